# Optimizing an MI355X kernel written in HIP

```python
import math
import jax, jax.numpy as jnp
from jax import lax
import numpy as np

D_MODEL = 1024
BATCH = 4
SEQ = 4096
DEPTH = 2

HEAD_DIM = 64
ROPE_THETA = 500000.0
ROPE_FRAC = 4
EPS = 1e-6
Q_BLOCK = 128

A_WIDTH = D_MODEL // 2
A_GROUPS = 4
A_GDIM = A_WIDTH // A_GROUPS
A_CHUNK = 128

B_HEADS = 8
B_QK_DIM = 32
B_V_DIM = 2 * B_QK_DIM
B_WIDTH = B_HEADS * B_V_DIM

C_WIDTH = D_MODEL // 2
C_KERNEL = 31

D_HEADS = 8
D_KV_GROUPS = 2
D_WIDTH = D_HEADS * HEAD_DIM
CMP_BLOCK = 32
CMP_STRIDE = 16
CMP_HIDDEN = 2 * HEAD_DIM
SLC_BLOCK = 64
SLC_TOPK = 16
WINDOW = 512

MEM_TOKENS = 256
M_HEADS = 4
M_WIDTH = M_HEADS * HEAD_DIM

MIX_WIDTH = A_WIDTH + B_WIDTH + M_WIDTH
EVEN_SPLITS = (A_WIDTH, A_WIDTH, A_WIDTH,
               2 * B_HEADS * B_QK_DIM, 2 * B_HEADS * B_QK_DIM, B_WIDTH, B_WIDTH,
               M_WIDTH, M_WIDTH)
ODD_SPLITS = (C_WIDTH, C_WIDTH, C_WIDTH,
              D_WIDTH, 6 * D_KV_GROUPS * HEAD_DIM, 3 * D_HEADS, D_WIDTH,
              M_WIDTH, M_WIDTH)
EVEN_IN = sum(EVEN_SPLITS)
ODD_IN = sum(ODD_SPLITS)

kernel_name = "hybrid_sgu_diffattn_conformer_nsa_block"


def rms_norm(x, g):
    xf = x.astype(jnp.float32)
    y = xf * lax.rsqrt(jnp.mean(xf * xf, axis=-1, keepdims=True) + EPS)
    return (y * g.astype(jnp.float32)).astype(x.dtype)


def rope_partial(x, pos):
    d = x.shape[-1]
    rd = d // ROPE_FRAC
    half = rd // 2
    inv = ROPE_THETA ** (-jnp.arange(half, dtype=jnp.float32) / half)
    ang = pos.astype(jnp.float32)[:, None] * inv[None, :]
    cos = jnp.cos(ang).astype(x.dtype)
    sin = jnp.sin(ang).astype(x.dtype)
    x1, x2, rest = x[..., :half], x[..., half:rd], x[..., rd:]
    return jnp.concatenate([x1 * cos - x2 * sin, x1 * sin + x2 * cos, rest], axis=-1)


def masked_softmax(s, mask):
    s = jnp.where(mask, s, -jnp.inf)
    m = jnp.max(s, axis=-1, keepdims=True)
    m = jnp.where(jnp.isfinite(m), m, 0.0)
    e = jnp.where(mask, jnp.exp(s - m), 0.0)
    return e / jnp.maximum(jnp.sum(e, axis=-1, keepdims=True), jnp.finfo(jnp.float32).tiny)


def split_cols(x, sizes):
    return jnp.split(x, [int(v) for v in np.cumsum(sizes)[:-1]], axis=-1)


def chunked_sgu(u, v, w_s, b_s, v_gain):
    Bz, S, _ = v.shape
    v = rms_norm(v.reshape(Bz, S, A_GROUPS, A_GDIM), v_gain.reshape(A_GROUPS, A_GDIM))
    v = v.reshape(Bz, S // A_CHUNK, A_CHUNK, A_GROUPS, A_GDIM)
    causal = jnp.tril(jnp.ones((A_CHUNK, A_CHUNK), dtype=bool))
    w = jnp.where(causal[None], w_s, 0.0)
    z = jnp.einsum('gts,bcsgd->bctgd', w, v) + b_s.T[:, :, None]
    return u * z.reshape(Bz, S, A_WIDTH)


def diff_attention(q, k, v, lam):
    Bz, H, _, S, dk = q.shape
    dv = v.shape[-1]
    nblk = S // Q_BLOCK
    scale = dk ** -0.5
    kpos = jnp.arange(S)
    qb = q.reshape(Bz, H, 2, nblk, Q_BLOCK, dk).transpose(3, 0, 1, 2, 4, 5)

    def block(args):
        qi, c = args
        qpos = c * Q_BLOCK + jnp.arange(Q_BLOCK)
        s = jnp.einsum('bhmqd,bhmkd->bhmqk', qi, k).astype(jnp.float32) * scale
        s = jnp.where(kpos[None, :] <= qpos[:, None], s, -jnp.inf)
        p = jax.nn.softmax(s, axis=-1)
        pd = p[:, :, 0] - lam * p[:, :, 1]
        return jnp.einsum('bhqk,bhkd->bhqd', pd.astype(v.dtype), v)

    o = lax.map(block, (qb, jnp.arange(nblk)))
    return o.transpose(1, 0, 3, 2, 4).reshape(Bz, S, H, dv)


def memory_attention(q, mem_n, w_kv, qnorm, knorm):
    Bz, S, _ = q.shape
    k, v = jnp.split(mem_n @ w_kv, 2, axis=-1)
    q = rms_norm(q.reshape(Bz, S, M_HEADS, HEAD_DIM), qnorm)
    k = rms_norm(k.reshape(Bz, -1, M_HEADS, HEAD_DIM), knorm)
    v = v.reshape(Bz, -1, M_HEADS, HEAD_DIM)
    s = jnp.einsum('bshd,bmhd->bhsm', q, k).astype(jnp.float32) * (HEAD_DIM ** -0.5)
    p = jax.nn.softmax(s, axis=-1)
    return jnp.einsum('bhsm,bmhd->bshd', p.astype(v.dtype), v).reshape(Bz, S, M_WIDTH)


def conformer_conv(a, b, conv_w, conv_b, norm_g):
    h = a * jax.nn.sigmoid(b)
    hp = jnp.pad(h, ((0, 0), (C_KERNEL - 1, 0), (0, 0)))
    y = lax.conv_general_dilated(hp, conv_w[:, None, :], window_strides=(1,), padding='VALID',
                                 dimension_numbers=('NWC', 'WIO', 'NWC'),
                                 feature_group_count=C_WIDTH) + conv_b
    return jax.nn.silu(rms_norm(y, norm_g))


def compress(t, cmp_idx, pos_emb, w1, w2):
    Bz, _, G, hd = t.shape
    blocks = t[:, cmp_idx] + pos_emb[:, None, :]
    flat = blocks.transpose(0, 1, 3, 2, 4).reshape(Bz, cmp_idx.shape[0], G, CMP_BLOCK * hd)
    return jax.nn.silu(flat @ w1) @ w2


def cmp_to_slc_overlap(n_cmp, n_slc):
    start = np.arange(n_cmp) * CMP_STRIDE
    s0 = np.arange(n_slc) * SLC_BLOCK
    lo = np.maximum(start[:, None], s0[None, :])
    hi = np.minimum(start[:, None] + CMP_BLOCK, s0[None, :] + SLC_BLOCK)
    return (np.clip(hi - lo, 0, None) / CMP_BLOCK).astype(np.float32)


def nsa(q, kv, gates, pos, qnorm, knorm, cmp_pos_k, cmp_w1_k, cmp_w2_k,
        cmp_pos_v, cmp_w1_v, cmp_w2_v):
    Bz, S = q.shape[:2]
    G, R, hd = D_KV_GROUPS, D_HEADS // D_KV_GROUPS, HEAD_DIM
    nblk = S // Q_BLOCK
    n_cmp = (S - CMP_BLOCK) // CMP_STRIDE + 1
    n_slc = S // SLC_BLOCK
    n_sel = min(SLC_TOPK, n_slc)
    scale = hd ** -0.5

    q = rope_partial(rms_norm(q, qnorm).transpose(0, 2, 1, 3), pos).reshape(Bz, G, R, S, hd)
    k_cmp_raw, v_cmp_raw, k_slc, v_slc, k_win, v_win = [kv[:, :, i] for i in range(6)]

    cmp_idx = np.arange(n_cmp)[:, None] * CMP_STRIDE + np.arange(CMP_BLOCK)[None, :]
    cmp_end = jnp.asarray(cmp_idx[:, -1])
    kc = compress(k_cmp_raw, cmp_idx, cmp_pos_k, cmp_w1_k, cmp_w2_k)
    vc = compress(v_cmp_raw, cmp_idx, cmp_pos_v, cmp_w1_v, cmp_w2_v).transpose(0, 2, 1, 3)
    kc = rope_partial(rms_norm(kc, knorm).transpose(0, 2, 1, 3), cmp_end)

    ks = rope_partial(rms_norm(k_slc, knorm).transpose(0, 2, 1, 3), pos)
    kb = ks.reshape(Bz, G, n_slc, SLC_BLOCK, hd)
    vb = v_slc.transpose(0, 2, 1, 3).reshape(Bz, G, n_slc, SLC_BLOCK, hd)

    pad = ((0, 0), (0, 0), (WINDOW, 0), (0, 0))
    kw = jnp.pad(rope_partial(rms_norm(k_win, knorm).transpose(0, 2, 1, 3), pos), pad)
    vw = jnp.pad(v_win.transpose(0, 2, 1, 3), pad)

    overlap = jnp.asarray(cmp_to_slc_overlap(n_cmp, n_slc))
    b_ix = jnp.arange(Bz)[:, None, None, None]
    g_ix = jnp.arange(G)[None, :, None, None]
    blk_tok = jnp.arange(SLC_BLOCK)
    slc_ids = jnp.arange(n_slc)
    win_off = jnp.arange(WINDOW + Q_BLOCK) - WINDOW

    qb = q.reshape(Bz, G, R, nblk, Q_BLOCK, hd).transpose(3, 0, 1, 2, 4, 5)
    gb = gates.transpose(0, 2, 1, 3).reshape(Bz, G, R, nblk, Q_BLOCK, 3).transpose(3, 0, 1, 2, 4, 5)

    def block(args):
        qi, gt, c = args
        qpos = c * Q_BLOCK + jnp.arange(Q_BLOCK)
        s = jnp.einsum('bgrqd,bgnd->bgrqn', qi, kc).astype(jnp.float32) * scale
        p_c = masked_softmax(s, cmp_end[None, :] <= qpos[:, None])
        o_c = jnp.einsum('bgrqn,bgnd->bgrqd', p_c.astype(vc.dtype), vc)
        imp = jnp.einsum('bgrqn,nj->bgqj', p_c, overlap)
        cur = (qpos // SLC_BLOCK)[:, None]
        imp = jnp.where(slc_ids[None, :] > cur, -jnp.inf, imp)
        forced = (slc_ids[None, :] == 0) | (slc_ids[None, :] == cur) | (slc_ids[None, :] == cur - 1)
        imp = jnp.where(forced, jnp.inf, imp)
        _, sel = lax.top_k(imp, n_sel)
        ksel = kb[b_ix, g_ix, sel].reshape(Bz, G, Q_BLOCK, n_sel * SLC_BLOCK, hd)
        vsel = vb[b_ix, g_ix, sel].reshape(Bz, G, Q_BLOCK, n_sel * SLC_BLOCK, hd)
        kpos = (sel[..., None] * SLC_BLOCK + blk_tok).reshape(Bz, G, Q_BLOCK, n_sel * SLC_BLOCK)
        s = jnp.einsum('bgrqd,bgqkd->bgrqk', qi, ksel).astype(jnp.float32) * scale
        p_s = masked_softmax(s, (kpos <= qpos[:, None])[:, :, None])
        o_s = jnp.einsum('bgrqk,bgqkd->bgrqd', p_s.astype(vsel.dtype), vsel)
        kwi = lax.dynamic_slice_in_dim(kw, c * Q_BLOCK, WINDOW + Q_BLOCK, axis=2)
        vwi = lax.dynamic_slice_in_dim(vw, c * Q_BLOCK, WINDOW + Q_BLOCK, axis=2)
        wpos = c * Q_BLOCK + win_off
        dpos = qpos[:, None] - wpos[None, :]
        s = jnp.einsum('bgrqd,bgkd->bgrqk', qi, kwi).astype(jnp.float32) * scale
        p_w = masked_softmax(s, (wpos[None, :] >= 0) & (dpos >= 0) & (dpos < WINDOW))
        o_w = jnp.einsum('bgrqk,bgkd->bgrqd', p_w.astype(vwi.dtype), vwi)
        return gt[..., 0:1] * o_c + gt[..., 1:2] * o_s + gt[..., 2:3] * o_w

    o = lax.map(block, (qb, gb, jnp.arange(nblk)))
    return o.transpose(1, 0, 4, 2, 3, 5).reshape(Bz, S, D_WIDTH)


def even_layer(x, mem_n, pos, layer, norm_g, w_in, a_vnorm, a_ws, a_bs, b_qnorm, b_knorm,
               b_lq1, b_lk1, b_lq2, b_lk2, b_subln, m_wkv, m_qnorm, m_knorm, w_out):
    Bz, S, _ = x.shape
    h = rms_norm(x, norm_g)
    a_u, a_v, a_g, b_q, b_k, b_v, b_g, m_q, m_g = split_cols(h @ w_in, EVEN_SPLITS)
    y_a = chunked_sgu(jax.nn.gelu(a_u), jax.nn.gelu(a_v), a_ws, a_bs, a_vnorm) * jax.nn.silu(a_g)
    lam_init = 0.8 - 0.6 * math.exp(-0.3 * layer)
    lam = (jnp.exp(jnp.sum(b_lq1.astype(jnp.float32) * b_lk1.astype(jnp.float32)))
           - jnp.exp(jnp.sum(b_lq2.astype(jnp.float32) * b_lk2.astype(jnp.float32))) + lam_init)
    q = rms_norm(b_q.reshape(Bz, S, B_HEADS, 2, B_QK_DIM), b_qnorm).transpose(0, 2, 3, 1, 4)
    k = rms_norm(b_k.reshape(Bz, S, B_HEADS, 2, B_QK_DIM), b_knorm).transpose(0, 2, 3, 1, 4)
    q, k = rope_partial(q, pos), rope_partial(k, pos)
    v = b_v.reshape(Bz, S, B_HEADS, B_V_DIM).transpose(0, 2, 1, 3)
    o_b = rms_norm(diff_attention(q, k, v, lam), b_subln) * (1.0 - lam_init)
    y_b = o_b.reshape(Bz, S, B_WIDTH) * jax.nn.silu(b_g)
    y_m = memory_attention(m_q, mem_n, m_wkv, m_qnorm, m_knorm) * jax.nn.silu(m_g)
    return x + jnp.concatenate([y_a, y_b, y_m], axis=-1) @ w_out


def odd_layer(x, mem_n, pos, norm_g, w_in, c_conv_w, c_conv_b, c_norm, d_qnorm, d_knorm,
              cmp_pos_k, cmp_w1_k, cmp_w2_k, cmp_pos_v, cmp_w1_v, cmp_w2_v,
              m_wkv, m_qnorm, m_knorm, w_out):
    Bz, S, _ = x.shape
    h = rms_norm(x, norm_g)
    c_a, c_b, c_g, d_q, d_kv, d_bg, d_g, m_q, m_g = split_cols(h @ w_in, ODD_SPLITS)
    y_c = conformer_conv(c_a, c_b, c_conv_w, c_conv_b, c_norm) * jax.nn.silu(c_g)
    kv = d_kv.reshape(Bz, S, 6, D_KV_GROUPS, HEAD_DIM)
    gates = jax.nn.sigmoid(d_bg.reshape(Bz, S, D_HEADS, 3))
    y_d = nsa(d_q.reshape(Bz, S, D_HEADS, HEAD_DIM), kv, gates, pos, d_qnorm, d_knorm,
              cmp_pos_k, cmp_w1_k, cmp_w2_k, cmp_pos_v, cmp_w1_v, cmp_w2_v) * jax.nn.silu(d_g)
    y_m = memory_attention(m_q, mem_n, m_wkv, m_qnorm, m_knorm) * jax.nn.silu(m_g)
    return x + jnp.concatenate([y_c, y_d, y_m], axis=-1) @ w_out


def setup_inputs(seed: int = 0) -> dict:
    key = jax.random.key(seed)
    keys = iter(jax.random.split(key, 48))

    def nrm(shape, scale):
        return jax.random.normal(next(keys), shape, jnp.float32) * scale

    def gain(n):
        return 1.0 + nrm((n,), 0.05)

    return {
        "x": nrm((BATCH, SEQ, D_MODEL), 1.0),
        "mem": nrm((BATCH, MEM_TOKENS, D_MODEL), 1.0),
        "mem_norm": gain(D_MODEL),
        "l0_norm": gain(D_MODEL),
        "l0_w_in": nrm((D_MODEL, EVEN_IN), D_MODEL ** -0.5),
        "l0_a_vnorm": gain(A_WIDTH),
        "l0_a_ws": nrm((A_GROUPS, A_CHUNK, A_CHUNK), A_CHUNK ** -0.5),
        "l0_a_bs": 1.0 + nrm((A_GROUPS, A_CHUNK), 0.1),
        "l0_b_qnorm": gain(B_QK_DIM),
        "l0_b_knorm": gain(B_QK_DIM),
        "l0_b_lq1": nrm((B_QK_DIM,), 0.1),
        "l0_b_lk1": nrm((B_QK_DIM,), 0.1),
        "l0_b_lq2": nrm((B_QK_DIM,), 0.1),
        "l0_b_lk2": nrm((B_QK_DIM,), 0.1),
        "l0_b_subln": gain(B_V_DIM),
        "l0_m_wkv": nrm((D_MODEL, 2 * M_WIDTH), D_MODEL ** -0.5),
        "l0_m_qnorm": gain(HEAD_DIM),
        "l0_m_knorm": gain(HEAD_DIM),
        "l0_w_out": nrm((MIX_WIDTH, D_MODEL), MIX_WIDTH ** -0.5),
        "l1_norm": gain(D_MODEL),
        "l1_w_in": nrm((D_MODEL, ODD_IN), D_MODEL ** -0.5),
        "l1_c_conv_w": nrm((C_KERNEL, C_WIDTH), C_KERNEL ** -0.5),
        "l1_c_conv_b": nrm((C_WIDTH,), 0.02),
        "l1_c_norm": gain(C_WIDTH),
        "l1_d_qnorm": gain(HEAD_DIM),
        "l1_d_knorm": gain(HEAD_DIM),
        "l1_d_cmp_pos_k": nrm((CMP_BLOCK, HEAD_DIM), 0.02),
        "l1_d_cmp_w1_k": nrm((CMP_BLOCK * HEAD_DIM, CMP_HIDDEN), (CMP_BLOCK * HEAD_DIM) ** -0.5),
        "l1_d_cmp_w2_k": nrm((CMP_HIDDEN, HEAD_DIM), CMP_HIDDEN ** -0.5),
        "l1_d_cmp_pos_v": nrm((CMP_BLOCK, HEAD_DIM), 0.02),
        "l1_d_cmp_w1_v": nrm((CMP_BLOCK * HEAD_DIM, CMP_HIDDEN), (CMP_BLOCK * HEAD_DIM) ** -0.5),
        "l1_d_cmp_w2_v": nrm((CMP_HIDDEN, HEAD_DIM), CMP_HIDDEN ** -0.5),
        "l1_m_wkv": nrm((D_MODEL, 2 * M_WIDTH), D_MODEL ** -0.5),
        "l1_m_qnorm": gain(HEAD_DIM),
        "l1_m_knorm": gain(HEAD_DIM),
        "l1_w_out": nrm((MIX_WIDTH, D_MODEL), MIX_WIDTH ** -0.5),
    }


def reference(x, mem, mem_norm,
              l0_norm, l0_w_in, l0_a_vnorm, l0_a_ws, l0_a_bs, l0_b_qnorm, l0_b_knorm,
              l0_b_lq1, l0_b_lk1, l0_b_lq2, l0_b_lk2, l0_b_subln, l0_m_wkv, l0_m_qnorm,
              l0_m_knorm, l0_w_out,
              l1_norm, l1_w_in, l1_c_conv_w, l1_c_conv_b, l1_c_norm, l1_d_qnorm, l1_d_knorm,
              l1_d_cmp_pos_k, l1_d_cmp_w1_k, l1_d_cmp_w2_k, l1_d_cmp_pos_v, l1_d_cmp_w1_v,
              l1_d_cmp_w2_v, l1_m_wkv, l1_m_qnorm, l1_m_knorm, l1_w_out):
    pos = jnp.arange(x.shape[1], dtype=jnp.int32)
    mem_n = rms_norm(mem, mem_norm)
    even_params = (l0_norm, l0_w_in, l0_a_vnorm, l0_a_ws, l0_a_bs, l0_b_qnorm, l0_b_knorm,
                   l0_b_lq1, l0_b_lk1, l0_b_lq2, l0_b_lk2, l0_b_subln, l0_m_wkv, l0_m_qnorm,
                   l0_m_knorm, l0_w_out)
    odd_params = (l1_norm, l1_w_in, l1_c_conv_w, l1_c_conv_b, l1_c_norm, l1_d_qnorm, l1_d_knorm,
                  l1_d_cmp_pos_k, l1_d_cmp_w1_k, l1_d_cmp_w2_k, l1_d_cmp_pos_v, l1_d_cmp_w1_v,
                  l1_d_cmp_w2_v, l1_m_wkv, l1_m_qnorm, l1_m_knorm, l1_w_out)
    for layer in range(DEPTH):
        if layer % 2 == 0:
            x = even_layer(x, mem_n, pos, layer + 1, *even_params)
        else:
            x = odd_layer(x, mem_n, pos, *odd_params)
    return x
```

```cpp
#include <hip/hip_runtime.h>
#include <hip/hip_cooperative_groups.h>
#include <cstdio>
#include <cstdint>
namespace cg = cooperative_groups;

#define DI __device__ __forceinline__
typedef unsigned short u16;
typedef unsigned long long u64;
using bf16x8 = __attribute__((ext_vector_type(8))) short;
using f32x16 = __attribute__((ext_vector_type(16))) float;
using u32x4 = __attribute__((ext_vector_type(4))) unsigned;

constexpr int BATCH = 4, SEQ = 4096, DM = 1024, T = BATCH * SEQ;
constexpr int LDP = 4096;
constexpr int ODD_IN = 3864, ODD_PAD = 3968;
constexpr int MIX = 1280;
constexpr float EPS = 1e-6f;
constexpr int A_U = 0, A_V = 512, A_G = 1024, B_Q = 1536, B_K = 2048, B_V = 2560, B_G = 3072, M0_Q = 3584, M0_G = 3840;
constexpr int C_A = 0, C_B = 512, C_G = 1024, D_Q = 1536, D_KV = 2048, D_G = 2816, M1_Q = 3328, M1_G = 3584, D_BG = 3840;
constexpr int NCMP = 255;

struct Params {
  const float *x, *mem, *mem_norm;
  const float *l0_norm, *l0_w_in, *a_vnorm, *a_ws, *a_bs, *b_qnorm, *b_knorm, *lq1, *lk1, *lq2, *lk2, *b_subln;
  const float *m0_wkv, *m0_qnorm, *m0_knorm, *l0_w_out;
  const float *l1_norm, *l1_w_in, *conv_w, *conv_b, *c_norm, *d_qnorm, *d_knorm;
  const float *pos_k, *w1_k, *w2_k, *pos_v, *w1_v, *w2_v;
  const float *m1_wkv, *m1_qnorm, *m1_knorm, *l1_w_out;
  float* out;
  u16 *h, *proj, *ycat, *winT0, *winT1, *woutT0, *woutT1, *wkvT0, *wkvT1, *memn, *memkv0, *memkv1, *kc, *vc, *vT, *memvT0, *memvT1, *vsT, *vwT, *vcT, *kd, *ksd, *kwd, *wsb, *w1T_k, *w1T_v;
  float *rope4, *rope8, *cbias;
  unsigned* bar;
  unsigned* qctr;
};

DI float bf2f(u16 u) { return __uint_as_float(((unsigned)u) << 16); }
DI u16 f2bf(float f) { unsigned u = __float_as_uint(f); u += 0x7fffu + ((u >> 16) & 1u); return (u16)(u >> 16); }
DI float wsum(float v) { for (int o = 32; o > 0; o >>= 1) v += __shfl_xor(v, o); return v; }
DI float wmax(float v) { for (int o = 32; o > 0; o >>= 1) v = fmaxf(v, __shfl_xor(v, o)); return v; }
DI float sigmoidf_(float x) { return __builtin_amdgcn_rcpf(1.f + __expf(-x)); }
DI float siluf_(float x) { return x * sigmoidf_(x); }
DI float geluf_(float x) { float u = 0.7978845608028654f * (x + 0.044715f * x * x * x); return x * __builtin_amdgcn_rcpf(1.f + __expf(-2.f * u)); }
DI void wave_sync() { __builtin_amdgcn_fence(__ATOMIC_SEQ_CST, "wavefront"); __builtin_amdgcn_wave_barrier(); }
DI int queue_pull(unsigned* ctr, int* slot) {
  __syncthreads();
  if (threadIdx.x == 0) *slot = (int)(gridDim.x + atomicAdd(ctr, 1u));
  __syncthreads();
  return *slot;
}
DI void ld8(const u16* p, float* v) {
  uint4 r = *(const uint4*)p;
  v[0] = __uint_as_float(r.x << 16); v[1] = __uint_as_float(r.x & 0xffff0000u);
  v[2] = __uint_as_float(r.y << 16); v[3] = __uint_as_float(r.y & 0xffff0000u);
  v[4] = __uint_as_float(r.z << 16); v[5] = __uint_as_float(r.z & 0xffff0000u);
  v[6] = __uint_as_float(r.w << 16); v[7] = __uint_as_float(r.w & 0xffff0000u);
}
DI void st8(u16* p, const float* v) {
  uint4 r;
  r.x = (unsigned)f2bf(v[0]) | ((unsigned)f2bf(v[1]) << 16);
  r.y = (unsigned)f2bf(v[2]) | ((unsigned)f2bf(v[3]) << 16);
  r.z = (unsigned)f2bf(v[4]) | ((unsigned)f2bf(v[5]) << 16);
  r.w = (unsigned)f2bf(v[6]) | ((unsigned)f2bf(v[7]) << 16);
  *(uint4*)p = r;
}

constexpr int GBK = 64, GLD = 72;
constexpr int SMEM_BYTES = 2 * 128 * GLD * 2;

DI void gemm_mainloop(f32x16 (&acc)[2][2], const u16* __restrict__ A, int lda, const u16* __restrict__ Bt, int ldb, int K, int m0, int n0,
                      u16* smem) {
  u16* As = smem;
  u16* Bs = smem + 128 * GLD;
  const int tid = threadIdx.x, lane = tid & 63, w = tid >> 6;
  const int wm = w >> 1, wn = w & 1;
  const int l31 = lane & 31, hh = lane >> 5;
#pragma unroll
  for (int i = 0; i < 2; ++i)
#pragma unroll
    for (int j = 0; j < 2; ++j)
#pragma unroll
      for (int r = 0; r < 16; ++r) acc[i][j][r] = 0.f;
  u32x4 ra[4], rb[4];
  const int nk = K / GBK;
#pragma unroll
  for (int i = 0; i < 4; ++i) {
    int c = tid + 256 * i, row = c >> 3, c8 = c & 7;
    ra[i] = *(const u32x4*)(A + (size_t)(m0 + row) * lda + c8 * 8);
    rb[i] = *(const u32x4*)(Bt + (size_t)(n0 + row) * ldb + c8 * 8);
  }
  for (int kt = 0; kt < nk; ++kt) {
    __syncthreads();
#pragma unroll
    for (int i = 0; i < 4; ++i) {
      int c = tid + 256 * i, row = c >> 3, c8 = c & 7;
      *(u32x4*)(As + row * GLD + c8 * 8) = ra[i];
      *(u32x4*)(Bs + row * GLD + c8 * 8) = rb[i];
    }
    __syncthreads();
    if (kt + 1 < nk) {
      const int k0 = (kt + 1) * GBK;
#pragma unroll
      for (int i = 0; i < 4; ++i) {
        int c = tid + 256 * i, row = c >> 3, c8 = c & 7;
        ra[i] = *(const u32x4*)(A + (size_t)(m0 + row) * lda + k0 + c8 * 8);
        rb[i] = *(const u32x4*)(Bt + (size_t)(n0 + row) * ldb + k0 + c8 * 8);
      }
    }
#pragma unroll
    for (int kk = 0; kk < 4; ++kk) {
      bf16x8 af[2], bfr[2];
#pragma unroll
      for (int i = 0; i < 2; ++i) {
        af[i] = *(const bf16x8*)(As + (wm * 64 + i * 32 + l31) * GLD + kk * 16 + hh * 8);
        bfr[i] = *(const bf16x8*)(Bs + (wn * 64 + i * 32 + l31) * GLD + kk * 16 + hh * 8);
      }
#pragma unroll
      for (int i = 0; i < 2; ++i)
#pragma unroll
        for (int j = 0; j < 2; ++j) acc[i][j] = __builtin_amdgcn_mfma_f32_32x32x16_bf16(af[i], bfr[j], acc[i][j], 0, 0, 0);
    }
  }
}

template <class Epi>
DI void gemm_tile(const u16* __restrict__ A, int lda, const u16* __restrict__ Bt, int ldb, int K, int m0, int n0,
                  u16* smem, Epi epi) {
  const int tid = threadIdx.x, lane = tid & 63, w = tid >> 6;
  const int wm = w >> 1, wn = w & 1;
  const int l31 = lane & 31, hh = lane >> 5;
  f32x16 acc[2][2];
  gemm_mainloop(acc, A, lda, Bt, ldb, K, m0, n0, smem);
#pragma unroll
  for (int i = 0; i < 2; ++i)
#pragma unroll
    for (int j = 0; j < 2; ++j)
#pragma unroll
      for (int r = 0; r < 16; ++r) {
        int row = m0 + wm * 64 + i * 32 + (r & 3) + 8 * (r >> 2) + 4 * hh;
        int col = n0 + wn * 64 + j * 32 + l31;
        epi(row, col, acc[i][j][r]);
      }
}

struct EpiBf16 {
  u16* C; int ldc; int N;
  DI void operator()(int row, int col, float v) const { if (col < N) C[(size_t)row * ldc + col] = f2bf(v); }
};
struct EpiResid {
  const float* X; float* O; int ld;
  DI void operator()(int row, int col, float v) const { size_t i = (size_t)row * ld + col; O[i] = X[i] + v; }
};
DI void gemm_tile_resid(const u16* __restrict__ A, int lda, const u16* __restrict__ Bt, int ldb, int K, int m0, int n0,
                        u16* smem, const float* X, float* O, int ld) {
  const int tid = threadIdx.x, lane = tid & 63, w = tid >> 6;
  const int wm = w >> 1, wn = w & 1;
  const int l31 = lane & 31, hh = lane >> 5;
  f32x16 acc[2][2];
  gemm_mainloop(acc, A, lda, Bt, ldb, K, m0, n0, smem);
#pragma unroll
  for (int i = 0; i < 2; ++i)
#pragma unroll
    for (int j = 0; j < 2; ++j) {
      const size_t base = (size_t)(m0 + wm * 64 + i * 32 + 4 * hh) * ld + n0 + wn * 64 + j * 32 + l31;
      float xv[16];
#pragma unroll
      for (int r = 0; r < 16; ++r) xv[r] = X[base + (size_t)((r & 3) + 8 * (r >> 2)) * ld];
#pragma unroll
      for (int r = 0; r < 16; ++r) O[base + (size_t)((r & 3) + 8 * (r >> 2)) * ld] = xv[r] + acc[i][j][r];
    }
}

DI void transpose_cvt_tile(const float* __restrict__ W, int K, int N, u16* __restrict__ WT, int item, float* tile, bool perm = false) {
  const int nkt = K / 64;
  const int kt = item % nkt, nt = item / nkt;
  const int k0 = kt * 64, n0 = nt * 64;
  __syncthreads();
  for (int i = threadIdx.x; i < 4096; i += 256) {
    int r = i >> 6, c = i & 63;
    int sc = n0 + c;
    if (perm) sc = sc < 2816 ? sc : sc < 3840 ? sc + 24 : sc < 3864 ? sc - 1024 : N;
    const float wvv = W[(size_t)(k0 + r) * N + (sc < N ? sc : N - 1)];
    float v = (sc < N) ? wvv : 0.f;
    tile[r * 65 + c] = v;
  }
  __syncthreads();
  for (int i = threadIdx.x; i < 4096; i += 256) {
    int r = i >> 6, c = i & 63;
    WT[(size_t)(n0 + r) * K + k0 + c] = f2bf(tile[c * 65 + r]);
  }
}

DI void rmsnorm_row(const float* __restrict__ src, const float* __restrict__ g, u16* __restrict__ dst, int lane) {
  float4 v[4];
  float ss = 0.f;
#pragma unroll
  for (int i = 0; i < 4; ++i) {
    v[i] = *(const float4*)(src + (i * 64 + lane) * 4);
    ss += v[i].x * v[i].x + v[i].y * v[i].y + v[i].z * v[i].z + v[i].w * v[i].w;
  }
  ss = wsum(ss);
  float rs = rsqrtf(ss * (1.f / 1024.f) + EPS);
#pragma unroll
  for (int i = 0; i < 4; ++i) {
    float4 gg = *(const float4*)(g + (i * 64 + lane) * 4);
    uint2 o;
    o.x = (unsigned)f2bf(v[i].x * rs * gg.x) | ((unsigned)f2bf(v[i].y * rs * gg.y) << 16);
    o.y = (unsigned)f2bf(v[i].z * rs * gg.z) | ((unsigned)f2bf(v[i].w * rs * gg.w) << 16);
    *(uint2*)(dst + (i * 64 + lane) * 4) = o;
  }
}

DI void phase0(const Params& p, float* smf) {
  const int n_win0 = 16 * 64, n_win1 = 16 * 62, n_wout = 20 * 16, n_wkv = 16 * 8;
  const int c1 = n_win0, c2 = c1 + n_win1, c3 = c2 + n_wout, c4 = c3 + n_wout, c5 = c4 + n_wkv, c6 = c5 + n_wkv;
  const int c7 = c6 + (1024 + T) / 4;
  const int c8 = c7 + 16;
  const int c9 = c8 + 64;
  const int c10 = c9 + 2 * 32 * 2;
  const int c11 = c10 + 64;
  const int lane = threadIdx.x & 63, w = threadIdx.x >> 6;
  for (int it = blockIdx.x; it < c11; it += gridDim.x) {
    if (it < c1) transpose_cvt_tile(p.l0_w_in, 1024, 4096, p.winT0, it, smf);
    else if (it < c2) transpose_cvt_tile(p.l1_w_in, 1024, ODD_IN, p.winT1, it - c1, smf, true);
    else if (it < c3) transpose_cvt_tile(p.l0_w_out, MIX, 1024, p.woutT0, it - c2, smf);
    else if (it < c4) transpose_cvt_tile(p.l1_w_out, MIX, 1024, p.woutT1, it - c3, smf);
    else if (it < c5) transpose_cvt_tile(p.m0_wkv, 1024, 512, p.wkvT0, it - c4, smf);
    else if (it < c6) transpose_cvt_tile(p.m1_wkv, 1024, 512, p.wkvT1, it - c5, smf);
    else if (it < c7) {
      int row = (it - c6) * 4 + w;
      if (row < 1024) rmsnorm_row(p.mem + (size_t)row * 1024, p.mem_norm, p.memn + (size_t)row * 1024, lane);
      else { row -= 1024; rmsnorm_row(p.x + (size_t)row * 1024, p.l0_norm, p.h + (size_t)row * 1024, lane); }
    } else if (it < c8) {
      int pos = (it - c7) * 256 + threadIdx.x;
      for (int i = 0; i < 4; ++i) {
        float inv = powf(500000.f, -(float)i / 4.f);
        float ang = (float)pos * inv;
        p.rope4[pos * 8 + i] = cosf(ang); p.rope4[pos * 8 + 4 + i] = sinf(ang);
      }
      for (int i = 0; i < 8; ++i) {
        float inv = powf(500000.f, -(float)i / 8.f);
        float ang = (float)pos * inv;
        p.rope8[pos * 16 + i] = cosf(ang); p.rope8[pos * 16 + 8 + i] = sinf(ang);
      }
    } else if (it >= c10) {
      const int e0 = (it - c10) * 1024;
      for (int e = e0 + threadIdx.x; e < e0 + 1024; e += 256) {
        const int t = (e >> 7) & 127, sidx = e & 127;
        p.wsb[e] = sidx <= t ? f2bf(p.a_ws[e]) : (u16)0;
      }
    } else if (it >= c9) {
      const int e = it - c9;
      if (e < 64) transpose_cvt_tile(p.w1_k, 2048, 128, p.w1T_k, e, smf);
      else transpose_cvt_tile(p.w1_v, 2048, 128, p.w1T_v, e - 64, smf);
    } else {
      const int which = (it - c8) >> 5, l = (it - c8) & 31;
      const float* pe = (which ? p.pos_v : p.pos_k) + l * 64;
      const float* w1 = (which ? p.w1_v : p.w1_k) + (size_t)l * 64 * 128;
      if (threadIdx.x < 128) {
        float a = 0.f;
#pragma unroll 8
        for (int k = 0; k < 64; ++k) a += pe[k] * w1[k * 128 + threadIdx.x];
        p.cbias[(which * 32 + l) * 128 + threadIdx.x] = a;
      }
    }
  }
}

DI void phase_gemm_in(const Params& p, int layer, u16* smem) {
  const u16* Bt = layer ? p.winT1 : p.winT0;
  const int N = layer ? ODD_IN : 4096;
  const int ntn = layer ? 31 : 32;
  const int main_items = (T / 128) * ntn;
  const int extra = layer ? 0 : 2 * 8 * 4;
  for (int it = blockIdx.x; it < main_items + extra; it += gridDim.x) {
    if (it < main_items) {
      int mt = it / ntn, nt = it % ntn;
      gemm_tile(p.h, 1024, Bt, 1024, 1024, mt * 128, nt * 128, smem, EpiBf16{p.proj, LDP, N});
    } else {
      int e = it - main_items;
      int l = e / 32, r = e % 32, mt = r / 4, nt = r % 4;
      gemm_tile(p.memn, 1024, l ? p.wkvT1 : p.wkvT0, 1024, 1024, mt * 128, nt * 128, smem,
                EpiBf16{l ? p.memkv1 : p.memkv0, 512, 512});
    }
  }
}
DI void phase_gemm_out(const Params& p, int layer, u16* smem) {
  const u16* Bt = layer ? p.woutT1 : p.woutT0;
  const float* X = layer ? p.out : p.x;
  const int items = (T / 128) * 8;
  for (int it = blockIdx.x; it < items; it += gridDim.x) {
    int mt = it / 8, nt = it % 8;
    gemm_tile_resid(p.ycat, MIX, Bt, MIX, MIX, mt * 128, nt * 128, smem, X, p.out, 1024);
  }
}

typedef __bf16 bf2_t __attribute__((ext_vector_type(2)));
typedef float f2_t __attribute__((ext_vector_type(2)));
DI unsigned pk_bf16(float a, float b) { f2_t v = {a, b}; bf2_t r = __builtin_convertvector(v, bf2_t); return __builtin_bit_cast(unsigned, r); }
#define MFMA32(a, b, c) __builtin_amdgcn_mfma_f32_32x32x16_bf16((a), (b), (c), 0, 0, 0)
constexpr int KLD = 72;
constexpr int KV_BUF = 2 * 64 * KLD;

struct FAState { f32x16 o[2]; float m, l; };
DI void fa_init(FAState& s) {
#pragma unroll
  for (int i = 0; i < 16; ++i) { s.o[0][i] = 0.f; s.o[1][i] = 0.f; }
  s.m = -INFINITY; s.l = 0.f;
}
DI bf16x8 frag_first(float v, int hh) {
  bf16x8 a = {0, 0, 0, 0, 0, 0, 0, 0};
  if (hh == 0) a[0] = (short)f2bf(v);
  return a;
}
DI bf16x8 scale_frag(const bf16x8& q, float c) {
  u32x4 u;
#pragma unroll
  for (int j = 0; j < 4; ++j) u[j] = pk_bf16(bf2f((u16)q[2 * j]) * c, bf2f((u16)q[2 * j + 1]) * c);
  return __builtin_bit_cast(bf16x8, u);
}
template <int DK>
DI void fa_scores(f32x16 (&s)[2], const bf16x8* qf, const u16* Ks, int l31, int hh, const bf16x8& aone, const bf16x8& qx) {
#pragma unroll
  for (int sub = 0; sub < 2; ++sub) {
#pragma unroll
    for (int i = 0; i < 16; ++i) s[sub][i] = 0.f;
    bf16x8 a[DK / 16];
#pragma unroll
    for (int ks = 0; ks < DK / 16; ++ks) a[ks] = *(const bf16x8*)(Ks + (sub * 32 + l31) * KLD + ks * 16 + hh * 8);
    __builtin_amdgcn_s_setprio(1);
#pragma unroll
    for (int ks = 0; ks < DK / 16; ++ks) s[sub] = MFMA32(a[ks], qf[ks], s[sub]);
    s[sub] = MFMA32(aone, qx, s[sub]);
    __builtin_amdgcn_s_setprio(0);
  }
}
DI void fa_mask(f32x16 (&s)[2], int k0, int lo, int hi, int hh) {
#pragma unroll
  for (int sub = 0; sub < 2; ++sub)
#pragma unroll
    for (int i = 0; i < 16; ++i) {
      const int key = k0 + sub * 32 + (i & 3) + 8 * (i >> 2) + 4 * hh;
      if (key < lo || key > hi) s[sub][i] = -INFINITY;
    }
}
DI bf16x8 pack8(const f32x16& x, int base) {
  u32x4 u;
  u[0] = pk_bf16(x[base + 0], x[base + 1]); u[1] = pk_bf16(x[base + 2], x[base + 3]);
  u[2] = pk_bf16(x[base + 4], x[base + 5]); u[3] = pk_bf16(x[base + 6], x[base + 7]);
  return __builtin_bit_cast(bf16x8, u);
}
DI void fa_pv(FAState& st, const bf16x8* pf, const u16* Vt, int l31, int hh) {
#pragma unroll
  for (int dsub = 0; dsub < 2; ++dsub) {
    bf16x8 vf[4];
#pragma unroll
    for (int ks = 0; ks < 4; ++ks) {
      vf[ks] = *(const bf16x8*)(Vt + (dsub * 32 + l31) * KLD + ks * 16 + 8 * hh);
    }
    __builtin_amdgcn_s_setprio(1);
#pragma unroll
    for (int ks = 0; ks < 4; ++ks) st.o[dsub] = MFMA32(vf[ks], pf[ks], st.o[dsub]);
    __builtin_amdgcn_s_setprio(0);
  }
}
DI void fa_softmax_pv(FAState& st, f32x16 (&s)[2], const u16* Vt, int l31, int hh) {
  float rs = 0.f;
#pragma unroll
  for (int sub = 0; sub < 2; ++sub)
#pragma unroll
    for (int i = 0; i < 16; ++i) { float pe = __builtin_amdgcn_exp2f(s[sub][i]); s[sub][i] = pe; rs += pe; }
  st.l += rs;
  bf16x8 pf[4];
#pragma unroll
  for (int ks = 0; ks < 4; ++ks) pf[ks] = pack8(s[ks >> 1], (ks & 1) * 8);
  fa_pv(st, pf, Vt, l31, hh);
}
DI float fa_rowsum(const FAState& st) { return st.l + __shfl_xor(st.l, 32); }
DI void fa_softmax_pack(FAState& st, f32x16 (&s)[2], bf16x8 (&pf)[4]) {
  float rs = 0.f;
#pragma unroll
  for (int sub = 0; sub < 2; ++sub)
#pragma unroll
    for (int i = 0; i < 16; ++i) { float pe = __builtin_amdgcn_exp2f(s[sub][i]); s[sub][i] = pe; rs += pe; }
  st.l += rs;
#pragma unroll
  for (int ks = 0; ks < 4; ++ks) pf[ks] = pack8(s[ks >> 1], (ks & 1) * 8);
}
DI void fa_pv2(FAState& st0, FAState& st1, const bf16x8* pf0, const bf16x8* pf1, const u16* Vt, int l31, int hh) {
#pragma unroll
  for (int dsub = 0; dsub < 2; ++dsub) {
    bf16x8 vf[4];
#pragma unroll
    for (int ks = 0; ks < 4; ++ks) {
      vf[ks] = *(const bf16x8*)(Vt + (dsub * 32 + l31) * KLD + ks * 16 + 8 * hh);
    }
    __builtin_amdgcn_s_setprio(1);
#pragma unroll
    for (int ks = 0; ks < 4; ++ks) { st0.o[dsub] = MFMA32(vf[ks], pf0[ks], st0.o[dsub]); st1.o[dsub] = MFMA32(vf[ks], pf1[ks], st1.o[dsub]); }
    __builtin_amdgcn_s_setprio(0);
  }
}
template <int NKS>
DI float q_norm2(const bf16x8* qf) {
  float ss = 0.f;
#pragma unroll
  for (int ks = 0; ks < NKS; ++ks)
#pragma unroll
    for (int j = 0; j < 8; ++j) { float v = bf2f((u16)qf[ks][j]); ss += v * v; }
  return ss + __shfl_xor(ss, 32);
}
DI float gain_absmax(const float* g, int n, int lane) { return wmax(lane < n ? fabsf(g[lane]) : 0.f); }

template <class Src, class Comp>
DI void kv_pipeline(int nsteps, u16* smem, Src src, Comp comp) {
  const int tid = threadIdx.x, r0 = tid >> 3, c8 = (tid & 7) * 8;
  u32x4 kr0, kr1, vr0, vr1;
  const u16 *kp, *vp; int ks, vs;
  if (nsteps <= 0) return;
  src(0, kp, ks, vp, vs);
  kr0 = *(const u32x4*)(kp + (size_t)r0 * ks + c8); kr1 = *(const u32x4*)(kp + (size_t)(r0 + 32) * ks + c8);
  vr0 = *(const u32x4*)(vp + (size_t)r0 * vs + c8); vr1 = *(const u32x4*)(vp + (size_t)(r0 + 32) * vs + c8);
  __syncthreads();
  *(u32x4*)(smem + r0 * KLD + c8) = kr0; *(u32x4*)(smem + (r0 + 32) * KLD + c8) = kr1;
  *(u32x4*)(smem + 64 * KLD + r0 * KLD + c8) = vr0; *(u32x4*)(smem + 64 * KLD + (r0 + 32) * KLD + c8) = vr1;
  __syncthreads();
  for (int t = 0; t < nsteps; ++t) {
    if (t + 1 < nsteps) {
      src(t + 1, kp, ks, vp, vs);
      kr0 = *(const u32x4*)(kp + (size_t)r0 * ks + c8); kr1 = *(const u32x4*)(kp + (size_t)(r0 + 32) * ks + c8);
      vr0 = *(const u32x4*)(vp + (size_t)r0 * vs + c8); vr1 = *(const u32x4*)(vp + (size_t)(r0 + 32) * vs + c8);
    }
    u16* Ks = smem + (t & 1) * KV_BUF;
    comp(t, (const u16*)Ks, (const u16*)(Ks + 64 * KLD));
    if (t + 1 < nsteps) {
      u16* nb = smem + ((t + 1) & 1) * KV_BUF;
      *(u32x4*)(nb + r0 * KLD + c8) = kr0; *(u32x4*)(nb + (r0 + 32) * KLD + c8) = kr1;
      *(u32x4*)(nb + 64 * KLD + r0 * KLD + c8) = vr0; *(u32x4*)(nb + 64 * KLD + (r0 + 32) * KLD + c8) = vr1;
    }
    __syncthreads();
  }
}

DI void transpose64(const u16* __restrict__ src, int lds, u16* __restrict__ dst, int ldd, u16* sm) {
  const int tid = threadIdx.x;
  __syncthreads();
  for (int c = tid; c < 512; c += 256) {
    int r = c >> 3, c8 = (c & 7) * 8;
    *(u32x4*)(sm + r * KLD + c8) = *(const u32x4*)(src + (size_t)r * lds + c8);
  }
  __syncthreads();
  const int d = tid >> 2, tc = tid & 3;
  unsigned u[8];
#pragma unroll
  for (int i = 0; i < 8; ++i)
    u[i] = (unsigned)sm[(tc * 16 + 2 * i) * KLD + d] | ((unsigned)sm[(tc * 16 + 2 * i + 1) * KLD + d] << 16);
  u32x4 a = {u[0], u[1], u[2], u[3]}, b = {u[4], u[5], u[6], u[7]};
  *(u32x4*)(dst + (size_t)d * ldd + tc * 16) = a;
  *(u32x4*)(dst + (size_t)d * ldd + tc * 16 + 8) = b;
}

DI void diffattn_item(const Params& p, int b, int h, int qt, float lam, u16* smem) {
  const int lane = threadIdx.x & 63, w = threadIdx.x >> 6, l31 = lane & 31, hh = lane >> 5;
  const int q0w = qt * 128 + w * 32, myq = q0w + l31;
  const size_t tok = (size_t)b * SEQ + myq;
  bf16x8 qf[2][2];
  {
    const u16* qrow = p.proj + tok * LDP + B_Q + h * 64;
#pragma unroll
    for (int m = 0; m < 2; ++m)
#pragma unroll
      for (int ks = 0; ks < 2; ++ks) qf[m][ks] = *(const bf16x8*)(qrow + m * 32 + ks * 16 + hh * 8);
  }
  FAState st[2];
  fa_init(st[0]); fa_init(st[1]);
  const u16* kbase = p.proj + (size_t)(b * SEQ) * LDP + B_K + h * 64;
  const u16* vtbase = p.vT + (size_t)(b * 8 + h) * SEQ * 64;
  const float c = 0.17677669529663687f * 1.4426950408889634f;
  const float kmax = 5.656854249f * 1.01f * gain_absmax(p.b_knorm, 32, lane);
  const bf16x8 aone = frag_first(1.f, hh);
  bf16x8 qx[2];
#pragma unroll
  for (int m = 0; m < 2; ++m) {
    qf[m][0] = scale_frag(qf[m][0], c); qf[m][1] = scale_frag(qf[m][1], c);
    qx[m] = frag_first(-kmax * sqrtf(q_norm2<2>(qf[m])), hh);
  }
  kv_pipeline(2 * qt + 2, smem,
    [&](int j, const u16*& kp, int& ks, const u16*& vp, int& vs) { kp = kbase + (size_t)(j * 64) * LDP; ks = LDP; vp = vtbase + (size_t)j * 4096; vs = 64; },
    [&](int j, const u16* Ks, const u16* Vt) {
      const int k0 = j * 64;
      if (k0 <= q0w + 31) {
        const bool need_mask = (k0 + 63 > q0w);
        bf16x8 pf[2][4];
#pragma unroll
        for (int m = 0; m < 2; ++m) {
          f32x16 s[2];
          fa_scores<32>(s, qf[m], Ks + m * 32, l31, hh, aone, qx[m]);
          if (need_mask) fa_mask(s, k0, 0, myq, hh);
          fa_softmax_pack(st[m], s, pf[m]);
          __builtin_amdgcn_sched_barrier(0);
        }
        fa_pv2(st[0], st[1], pf[0], pf[1], Vt, l31, hh);
        __builtin_amdgcn_sched_barrier(0);
      }
    });
  const float i0 = 1.f / fa_rowsum(st[0]), i1 = lam / fa_rowsum(st[1]);
  float ss = 0.f;
#pragma unroll
  for (int d = 0; d < 2; ++d)
#pragma unroll
    for (int i = 0; i < 16; ++i) { float o = st[0].o[d][i] * i0 - st[1].o[d][i] * i1; st[0].o[d][i] = o; ss += o * o; }
  ss += __shfl_xor(ss, 32);
  const float lam_init = 0.8f - 0.6f * 0.7408182206817179f;
  const float rs = rsqrtf(ss * (1.f / 64.f) + EPS) * (1.f - lam_init);
  uint2 gqs[2][4];
#pragma unroll
  for (int d = 0; d < 2; ++d)
#pragma unroll
    for (int a = 0; a < 4; ++a) gqs[d][a] = *(const uint2*)(p.proj + tok * LDP + B_G + h * 64 + d * 32 + 8 * a + 4 * hh);
#pragma unroll
  for (int d = 0; d < 2; ++d)
#pragma unroll
    for (int a = 0; a < 4; ++a) {
      const int dim = d * 32 + 8 * a + 4 * hh;
      uint2 gq = gqs[d][a];
      float g0 = __uint_as_float(gq.x << 16), g1 = __uint_as_float(gq.x & 0xffff0000u);
      float g2 = __uint_as_float(gq.y << 16), g3 = __uint_as_float(gq.y & 0xffff0000u);
      float y0 = st[0].o[d][4 * a + 0] * rs * p.b_subln[dim + 0] * siluf_(g0);
      float y1 = st[0].o[d][4 * a + 1] * rs * p.b_subln[dim + 1] * siluf_(g1);
      float y2 = st[0].o[d][4 * a + 2] * rs * p.b_subln[dim + 2] * siluf_(g2);
      float y3 = st[0].o[d][4 * a + 3] * rs * p.b_subln[dim + 3] * siluf_(g3);
      uint2 o; o.x = pk_bf16(y0, y1); o.y = pk_bf16(y2, y3);
      *(uint2*)(p.ycat + tok * MIX + 512 + h * 64 + dim) = o;
    }
}

DI void memattn_item(const Params& p, int layer, int b, int h, int qt, u16* smem) {
  const int lane = threadIdx.x & 63, w = threadIdx.x >> 6, l31 = lane & 31, hh = lane >> 5;
  const int myq = qt * 128 + w * 32 + l31;
  const size_t tok = (size_t)b * SEQ + myq;
  const int qcol = layer ? M1_Q : M0_Q, gcol = layer ? M1_G : M0_G;
  bf16x8 qf[4];
#pragma unroll
  for (int ks = 0; ks < 4; ++ks) qf[ks] = *(const bf16x8*)(p.proj + tok * LDP + qcol + h * 64 + ks * 16 + hh * 8);
  FAState st; fa_init(st);
  const u16* kbase = (layer ? p.memkv1 : p.memkv0) + (size_t)(b * 256) * 512 + h * 64;
  const u16* vtbase = (layer ? p.memvT1 : p.memvT0) + (size_t)((b * 4 + h) * 64) * 256;
  const float c = 0.125f * 1.4426950408889634f;
#pragma unroll
  for (int ks = 0; ks < 4; ++ks) qf[ks] = scale_frag(qf[ks], c);
  const bf16x8 aone = frag_first(1.f, hh);
  const bf16x8 qx = frag_first(-8.f * 1.01f * gain_absmax(layer ? p.m1_knorm : p.m0_knorm, 64, lane) * sqrtf(q_norm2<4>(qf)), hh);
  kv_pipeline(4, smem,
    [&](int j, const u16*& kp, int& ks, const u16*& vp, int& vs) { kp = kbase + (size_t)(j * 64) * 512; ks = 512; vp = vtbase + j * 64; vs = 256; },
    [&](int j, const u16* Ks, const u16* Vt) {
      f32x16 s[2];
      fa_scores<64>(s, qf, Ks, l31, hh, aone, qx);
      fa_softmax_pv(st, s, Vt, l31, hh);
    });
  const float il = 1.f / fa_rowsum(st);
  uint2 gqs[2][4];
#pragma unroll
  for (int d = 0; d < 2; ++d)
#pragma unroll
    for (int a = 0; a < 4; ++a) gqs[d][a] = *(const uint2*)(p.proj + tok * LDP + gcol + h * 64 + d * 32 + 8 * a + 4 * hh);
#pragma unroll
  for (int d = 0; d < 2; ++d)
#pragma unroll
    for (int a = 0; a < 4; ++a) {
      const int dim = d * 32 + 8 * a + 4 * hh;
      uint2 gq = gqs[d][a];
      float g0 = __uint_as_float(gq.x << 16), g1 = __uint_as_float(gq.x & 0xffff0000u);
      float g2 = __uint_as_float(gq.y << 16), g3 = __uint_as_float(gq.y & 0xffff0000u);
      uint2 o;
      o.x = pk_bf16(st.o[d][4 * a + 0] * il * siluf_(g0), st.o[d][4 * a + 1] * il * siluf_(g1));
      o.y = pk_bf16(st.o[d][4 * a + 2] * il * siluf_(g2), st.o[d][4 * a + 3] * il * siluf_(g3));
      *(uint2*)(p.ycat + tok * MIX + 1024 + h * 64 + dim) = o;
    }
}

constexpr int SLD = 136;
DI void sgu_item_mfma(const Params& p, int item, u16* smem) {
  const int g = item & 3; item >>= 2;
  const int cidx = item & 31; item >>= 5;
  const int b = item;
  const int tok0 = b * SEQ + cidx * 128;
  const int tid = threadIdx.x, lane = tid & 63, w = tid >> 6, l31 = lane & 31, hh = lane >> 5;
  __syncthreads();
  for (int i = tid; i < 2048; i += 256) {
    const int s = i & 127, c8 = (i >> 7) * 8;
    u32x4 v = *(const u32x4*)(p.proj + (size_t)(tok0 + s) * LDP + A_V + g * 128 + c8);
#pragma unroll
    for (int e = 0; e < 4; ++e) {
      smem[(c8 + 2 * e) * SLD + s] = (u16)(v[e] & 0xffffu);
      smem[(c8 + 2 * e + 1) * SLD + s] = (u16)(v[e] >> 16);
    }
  }
  __syncthreads();
  f32x16 acc[4];
#pragma unroll
  for (int ti = 0; ti < 4; ++ti)
#pragma unroll
    for (int i = 0; i < 16; ++i) acc[ti][i] = 0.f;
  const u16* Wb = p.wsb + (size_t)g * 128 * 128;
#pragma unroll
  for (int ks = 0; ks < 8; ++ks) {
    const bf16x8 bfr = *(const bf16x8*)(smem + (w * 32 + l31) * SLD + ks * 16 + hh * 8);
#pragma unroll
    for (int ti = 0; ti < 4; ++ti) {
      if (ks * 16 <= ti * 32 + 31) {
        const bf16x8 af = *(const bf16x8*)(Wb + (ti * 32 + l31) * 128 + ks * 16 + hh * 8);
        acc[ti] = MFMA32(af, bfr, acc[ti]);
      }
    }
  }
  const int d = w * 32 + l31;
#pragma unroll
  for (int ti = 0; ti < 4; ++ti) {
    u16 uv[16], gv[16];
    float bs[16];
#pragma unroll
    for (int i = 0; i < 16; ++i) {
      const int t = ti * 32 + (i & 3) + 8 * (i >> 2) + 4 * hh;
      const u16* row = p.proj + (size_t)(tok0 + t) * LDP;
      uv[i] = row[A_U + g * 128 + d]; gv[i] = row[A_G + g * 128 + d]; bs[i] = p.a_bs[g * 128 + t];
    }
#pragma unroll
    for (int i = 0; i < 16; ++i) {
      const int t = ti * 32 + (i & 3) + 8 * (i >> 2) + 4 * hh;
      const float z = acc[ti][i] + bs[i];
      p.ycat[(size_t)(tok0 + t) * MIX + g * 128 + d] = f2bf(geluf_(bf2f(uv[i])) * z * siluf_(bf2f(gv[i])));
    }
  }
}

DI void compress_item_mfma(const Params& p, int item, float* smf) {
  const int nch = item & 7; item >>= 3;
  const int g = item & 1; item >>= 1;
  const int b = item & 3; item >>= 2;
  const int which = item;
  const int tid = threadIdx.x, lane = tid & 63, w = tid >> 6, l31 = lane & 31, hh = lane >> 5;
  const int n0 = nch * 32;
  const int nrow = min(n0 + l31, NCMP - 1);
  u16* As = (u16*)smf;
  u16* Bs = (u16*)smf + 32 * KLD;
  const int arow = tid >> 3, ac8 = (tid & 7) * 8;
  const u16* asrc = p.proj + (size_t)(b * SEQ + 16 * min(n0 + arow, NCMP - 1)) * LDP + D_KV + which * 128 + g * 64 + ac8;
  const u16* bsrc = (which ? p.w1T_v : p.w1T_k) + (size_t)arow * 2048 + ac8;
  (void)nrow;
  f32x16 acc;
#pragma unroll
  for (int i = 0; i < 16; ++i) acc[i] = 0.f;
  u32x4 ra, rb0, rb1, rb2, rb3;
  ra = *(const u32x4*)(asrc);
  rb0 = *(const u32x4*)(bsrc); rb1 = *(const u32x4*)(bsrc + (size_t)32 * 2048);
  rb2 = *(const u32x4*)(bsrc + (size_t)64 * 2048); rb3 = *(const u32x4*)(bsrc + (size_t)96 * 2048);
#pragma unroll 2
  for (int l = 0; l < 32; ++l) {
    __syncthreads();
    *(u32x4*)(As + arow * KLD + ac8) = ra;
    *(u32x4*)(Bs + arow * KLD + ac8) = rb0; *(u32x4*)(Bs + (arow + 32) * KLD + ac8) = rb1;
    *(u32x4*)(Bs + (arow + 64) * KLD + ac8) = rb2; *(u32x4*)(Bs + (arow + 96) * KLD + ac8) = rb3;
    __syncthreads();
    {
      const int ln = l + 1 < 32 ? l + 1 : 31;
      ra = *(const u32x4*)(asrc + (size_t)ln * LDP);
      const u16* bp = bsrc + ln * 64;
      rb0 = *(const u32x4*)(bp); rb1 = *(const u32x4*)(bp + (size_t)32 * 2048);
      rb2 = *(const u32x4*)(bp + (size_t)64 * 2048); rb3 = *(const u32x4*)(bp + (size_t)96 * 2048);
    }
#pragma unroll
    for (int kk = 0; kk < 4; ++kk) {
      const bf16x8 af = *(const bf16x8*)(As + l31 * KLD + kk * 16 + hh * 8);
      const bf16x8 bfr = *(const bf16x8*)(Bs + (w * 32 + l31) * KLD + kk * 16 + hh * 8);
      acc = MFMA32(af, bfr, acc);
    }
  }
  float* hid = smf;
  float* biasL = smf + 32 * 132;
  const float* w2 = which ? p.w2_v : p.w2_k;
  __syncthreads();
  if (tid < 128) {
    float s = 0.f;
#pragma unroll 4
    for (int l = 0; l < 32; ++l) s += p.cbias[(which * 32 + l) * 128 + tid];
    biasL[tid] = s;
  }
  __syncthreads();
#pragma unroll
  for (int i = 0; i < 16; ++i) {
    const int r = (i & 3) + 8 * (i >> 2) + 4 * hh, j = w * 32 + l31;
    hid[r * 132 + j] = siluf_(acc[i] + biasL[j]);
  }
  __syncthreads();
  const int r = tid >> 3, e0 = (tid & 7) * 8;
  float o[8];
#pragma unroll
  for (int e = 0; e < 8; ++e) o[e] = 0.f;
#pragma unroll 4
  for (int j = 0; j < 128; ++j) {
    const float hv = hid[r * 132 + j];
    const float4 wa = *(const float4*)(w2 + j * 64 + e0), wb = *(const float4*)(w2 + j * 64 + e0 + 4);
    o[0] += hv * wa.x; o[1] += hv * wa.y; o[2] += hv * wa.z; o[3] += hv * wa.w;
    o[4] += hv * wb.x; o[5] += hv * wb.y; o[6] += hv * wb.z; o[7] += hv * wb.w;
  }
  const int n = n0 + r;
  if (which == 0) {
    float ss = 0.f;
#pragma unroll
    for (int e = 0; e < 8; ++e) ss += o[e] * o[e];
    ss += __shfl_xor(ss, 1); ss += __shfl_xor(ss, 2); ss += __shfl_xor(ss, 4);
    const float rs = rsqrtf(ss * (1.f / 64.f) + EPS);
#pragma unroll
    for (int e = 0; e < 8; ++e) o[e] = o[e] * rs * p.d_knorm[e0 + e];
    const float* cs = p.rope8 + (16 * min(n, NCMP - 1) + 31) * 16;
    const int sub = tid & 7;
#pragma unroll
    for (int e = 0; e < 8; ++e) {
      const float other = __shfl_xor(o[e], 1);
      if (sub == 0) o[e] = o[e] * cs[e] - other * cs[8 + e];
      else if (sub == 1) o[e] = other * cs[8 + e] + o[e] * cs[e];
    }
    if (n >= NCMP) {
#pragma unroll
      for (int e = 0; e < 8; ++e) o[e] = 0.f;
    }
    st8(p.kc + ((size_t)((b * 2 + g) * 256 + n)) * 64 + e0, o);
  } else {
#pragma unroll
    for (int e = 0; e < 8; ++e)
      p.vcT[((size_t)((b * 2 + g) * 64 + e0 + e)) * 256 + ((n & ~15) | ((n & 4) << 1) | ((n & 8) >> 1) | (n & 3))] = (n >= NCMP) ? (u16)0 : f2bf(o[e]);
  }
}

template <bool EDGE>
DI void conv_pass(const Params& p, const u16* base, int t0, int c, float* ys, float (&ssq)[16]) {
  float hv[46];
#pragma unroll
  for (int r = 0; r < 46; ++r) {
    const int ts = t0 - 30 + r;
    if (EDGE) hv[r] = ts >= 0 ? bf2f(base[(size_t)ts * LDP + c]) * sigmoidf_(bf2f(base[(size_t)ts * LDP + (C_B - C_A) + c])) : 0.f;
    else hv[r] = bf2f(base[(size_t)ts * LDP + c]) * sigmoidf_(bf2f(base[(size_t)ts * LDP + (C_B - C_A) + c]));
  }
  float y[16];
  const float bias = p.conv_b[c];
#pragma unroll
  for (int i = 0; i < 16; ++i) y[i] = bias;
#pragma unroll
  for (int j = 0; j < 31; ++j) {
    const float wv = p.conv_w[j * 512 + c];
#pragma unroll
    for (int i = 0; i < 16; ++i) y[i] += hv[i + j] * wv;
  }
#pragma unroll
  for (int i = 0; i < 16; ++i) { ssq[i] += y[i] * y[i]; ys[i * 512 + c] = y[i]; }
}
DI void conv_item2(const Params& p, int item, float* smf) {
  const int tt = item & 255, b = item >> 8;
  const int t0 = tt * 16, tid = threadIdx.x, lane = tid & 63, w = tid >> 6;
  const u16* base = p.proj + (size_t)(b * SEQ) * LDP + C_A;
  float* ys = smf;
  float* red = smf + 16 * 512;
  float ssq[16];
#pragma unroll
  for (int i = 0; i < 16; ++i) ssq[i] = 0.f;
  __syncthreads();
#pragma unroll 1
  for (int cc = 0; cc < 2; ++cc) {
    const int c = tid + cc * 256;
    if (t0 >= 32) conv_pass<false>(p, base, t0, c, ys, ssq);
    else conv_pass<true>(p, base, t0, c, ys, ssq);
  }
#pragma unroll
  for (int i = 0; i < 16; ++i) ssq[i] = wsum(ssq[i]);
  if (lane == 0) {
#pragma unroll
    for (int i = 0; i < 16; ++i) red[w * 16 + i] = ssq[i];
  }
  __syncthreads();
  float rsv[16];
#pragma unroll
  for (int i = 0; i < 16; ++i) rsv[i] = rsqrtf((red[i] + red[16 + i] + red[32 + i] + red[48 + i]) * (1.f / 512.f) + EPS);
#pragma unroll 1
  for (int cc = 0; cc < 2; ++cc) {
    const int c = tid + cc * 256;
    const float cn = p.c_norm[c];
    u16 gtv[16];
#pragma unroll
    for (int i = 0; i < 16; ++i) gtv[i] = p.proj[((size_t)b * SEQ + t0 + i) * LDP + C_G + c];
#pragma unroll
    for (int i = 0; i < 16; ++i) {
      const float yy = siluf_(ys[i * 512 + c] * rsv[i] * cn);
      p.ycat[((size_t)b * SEQ + t0 + i) * MIX + c] = f2bf(yy * siluf_(bf2f(gtv[i])));
    }
  }
}

constexpr int HLD = 264;
DI void conv_item4(const Params& p, int item, float* smf) {
  const int tt = item & 255, b = item >> 8;
  const int t0 = tt * 16, tid = threadIdx.x, lane = tid & 63, w = tid >> 6;
  const u16* base = p.proj + (size_t)(b * SEQ) * LDP + C_A;
  u16* hs = (u16*)smf;
  float* red = smf + (46 * HLD * 2 + 15) / 16 * 4;
  float yA[16], yB[16];
  float ssq[16];
#pragma unroll
  for (int i = 0; i < 16; ++i) ssq[i] = 0.f;
#pragma unroll 1
  for (int half = 0; half < 2; ++half) {
    __syncthreads();
#pragma unroll 2
    for (int it = 0; it < 6; ++it) {
      const int ci = tid + it * 256;
      if (ci < 46 * 32) {
        const int r = ci >> 5, c8 = (ci & 31) * 8;
        const int ts = t0 - 30 + r, tsc = ts > 0 ? ts : 0;
        float av[8], bv[8];
        ld8(base + (size_t)tsc * LDP + half * 256 + c8, av);
        ld8(base + (size_t)tsc * LDP + (C_B - C_A) + half * 256 + c8, bv);
#pragma unroll
        for (int e = 0; e < 8; ++e) av[e] = ts >= 0 ? av[e] * sigmoidf_(bv[e]) : 0.f;
        st8(hs + r * HLD + c8, av);
      }
    }
    __syncthreads();
    const int c = half * 256 + tid;
    float hv[46];
#pragma unroll
    for (int r = 0; r < 46; ++r) hv[r] = bf2f(hs[r * HLD + tid]);
    const float bias = p.conv_b[c];
    float yy[16];
#pragma unroll
    for (int i = 0; i < 16; ++i) yy[i] = bias;
#pragma unroll
    for (int j = 0; j < 31; ++j) {
      const float wv = p.conv_w[j * 512 + c];
#pragma unroll
      for (int i = 0; i < 16; ++i) yy[i] += hv[i + j] * wv;
    }
#pragma unroll
    for (int i = 0; i < 16; ++i) { ssq[i] += yy[i] * yy[i]; if (half == 0) yA[i] = yy[i]; else yB[i] = yy[i]; }
  }
#pragma unroll
  for (int i = 0; i < 16; ++i) ssq[i] = wsum(ssq[i]);
  if (lane == 0) {
#pragma unroll
    for (int i = 0; i < 16; ++i) red[w * 16 + i] = ssq[i];
  }
  __syncthreads();
  float rsv[16];
#pragma unroll
  for (int i = 0; i < 16; ++i) rsv[i] = rsqrtf((red[i] + red[16 + i] + red[32 + i] + red[48 + i]) * (1.f / 512.f) + EPS);
#pragma unroll 1
  for (int half = 0; half < 2; ++half) {
    const int c = half * 256 + tid;
    const float cn = p.c_norm[c];
    u16 gtv[16];
#pragma unroll
    for (int i = 0; i < 16; ++i) gtv[i] = p.proj[((size_t)b * SEQ + t0 + i) * LDP + C_G + c];
#pragma unroll
    for (int i = 0; i < 16; ++i) {
      const float yy = siluf_((half ? yB[i] : yA[i]) * rsv[i] * cn);
      p.ycat[((size_t)b * SEQ + t0 + i) * MIX + c] = f2bf(yy * siluf_(bf2f(gtv[i])));
    }
  }
}

template <int L>
DI float group_rs(const float* v) {
  float ss = 0.f;
#pragma unroll
  for (int i = 0; i < 8; ++i) ss += v[i] * v[i];
#pragma unroll
  for (int o = 1; o < L; o <<= 1) ss += __shfl_xor(ss, o);
  return rsqrtf(ss * (1.f / (8.f * L)) + EPS);
}

DI void prep0_token(const Params& p, int tok, int lane) {
  u16* row = p.proj + (size_t)tok * LDP;
  const int t = tok & (SEQ - 1);
  float v[8];
#pragma unroll
  for (int which = 0; which < 2; ++which) {
    u16* ptr = row + (which ? B_K : B_Q) + lane * 8;
    const float* g = which ? p.b_knorm : p.b_qnorm;
    ld8(ptr, v);
    float rs = group_rs<4>(v);
#pragma unroll
    for (int i = 0; i < 8; ++i) v[i] = v[i] * rs * g[(lane & 3) * 8 + i];
    if ((lane & 3) == 0) {
      const float* cs = p.rope4 + t * 8;
#pragma unroll
      for (int i = 0; i < 4; ++i) {
        float x1 = v[i], x2 = v[4 + i], c = cs[i], s = cs[4 + i];
        v[i] = x1 * c - x2 * s; v[4 + i] = x1 * s + x2 * c;
      }
    }
    if (which) st8(p.kd + ((size_t)((tok >> 12) * 8 + (lane >> 3)) * SEQ + t) * 64 + (lane & 7) * 8, v);
    else st8(ptr, v);
  }
  {
    u16* ptr = row + A_V + lane * 8;
    ld8(ptr, v);
#pragma unroll
    for (int i = 0; i < 8; ++i) v[i] = geluf_(v[i]);
    float rs = group_rs<16>(v);
#pragma unroll
    for (int i = 0; i < 8; ++i) v[i] = v[i] * rs * p.a_vnorm[lane * 8 + i];
    st8(ptr, v);
  }
  {
    const int l2 = lane & 31;
    u16* ptr = row + M0_Q + l2 * 8;
    ld8(ptr, v);
    float rs = group_rs<8>(v);
#pragma unroll
    for (int i = 0; i < 8; ++i) v[i] = v[i] * rs * p.m0_qnorm[(l2 & 7) * 8 + i];
    if (lane < 32) st8(ptr, v);
  }
}

DI void memk_norm_row(u16* rowp, const float* g, int lane) {
  float v[8];
  const int l2 = lane & 31;
  u16* ptr = rowp + l2 * 8;
  ld8(ptr, v);
  float rs = group_rs<8>(v);
#pragma unroll
  for (int i = 0; i < 8; ++i) v[i] = v[i] * rs * g[(l2 & 7) * 8 + i];
  if (lane < 32) st8(ptr, v);
}

DI void phase_prep0(const Params& p, u16* smem) {
  const int lane = threadIdx.x & 63, w = threadIdx.x >> 6;
  const int n_row = (T + 2048) / 4, n_vt = BATCH * 8 * 64, n_mvt = 2 * BATCH * 4 * 4;
  for (int it = blockIdx.x; it < n_row + n_vt + n_mvt; it += gridDim.x) {
    if (it < n_vt) {
      const int tt = it & 63, bh = it >> 6;
      const int b = bh >> 3, h = bh & 7;
      transpose64(p.proj + (size_t)(b * SEQ + tt * 64) * LDP + B_V + h * 64, LDP, p.vT + (size_t)(bh * 64 + tt) * 4096, 64, smem);
    } else if (it < n_vt + n_mvt) {
      int e = it - n_vt;
      const int mt = e & 3; e >>= 2;
      const int h = e & 3; e >>= 2;
      const int b = e & 3; e >>= 2;
      const int l = e;
      transpose64((l ? p.memkv1 : p.memkv0) + (size_t)(b * 256 + mt * 64) * 512 + 256 + h * 64, 512,
                  (l ? p.memvT1 : p.memvT0) + (size_t)((b * 4 + h) * 64) * 256 + mt * 64, 256, smem);
    } else {
      int r = (it - n_vt - n_mvt) * 4 + w;
      if (r < T) prep0_token(p, r, lane);
      else {
        r -= T;
        if (r < 1024) memk_norm_row(p.memkv0 + (size_t)r * 512, p.m0_knorm, lane);
        else memk_norm_row(p.memkv1 + (size_t)(r - 1024) * 512, p.m1_knorm, lane);
      }
    }
  }
}

DI void prep1_token(const Params& p, int tok, int lane) {
  u16* row = p.proj + (size_t)tok * LDP;
  const int t = tok & (SEQ - 1);
  const float* cs = p.rope8 + t * 16;
  float v[8];
  {
    u16* ptr = row + D_Q + lane * 8;
    ld8(ptr, v);
    float rs = group_rs<8>(v);
#pragma unroll
    for (int i = 0; i < 8; ++i) v[i] = v[i] * rs * p.d_qnorm[(lane & 7) * 8 + i];
    const int sub = lane & 7;
#pragma unroll
    for (int i = 0; i < 8; ++i) {
      float other = __shfl_xor(v[i], 1);
      float c = cs[i], s = cs[8 + i];
      if (sub == 0) v[i] = v[i] * c - other * s;
      else if (sub == 1) v[i] = other * s + v[i] * c;
    }
    st8(ptr, v);
  }
  {
    int col = lane < 16 ? (D_KV + 2 * 128 + lane * 8) : lane < 32 ? (D_KV + 4 * 128 + (lane - 16) * 8) : (M1_Q + (lane - 32) * 8);
    const float* g = lane < 32 ? p.d_knorm : p.m1_qnorm;
    u16* ptr = row + col;
    ld8(ptr, v);
    float rs = group_rs<8>(v);
#pragma unroll
    for (int i = 0; i < 8; ++i) v[i] = v[i] * rs * g[(lane & 7) * 8 + i];
    const int sub = lane & 7;
#pragma unroll
    for (int i = 0; i < 8; ++i) {
      float other = __shfl_xor(v[i], 1);
      float c = cs[i], s = cs[8 + i];
      if (lane < 32) {
        if (sub == 0) v[i] = v[i] * c - other * s;
        else if (sub == 1) v[i] = other * s + v[i] * c;
      }
    }
    if (lane < 32) st8((lane < 16 ? p.ksd : p.kwd) + ((size_t)((tok >> 12) * 2 + ((lane >> 3) & 1)) * SEQ + t) * 64 + (lane & 7) * 8, v);
    else st8(ptr, v);
  }
  {
    float b[8];
    u16* ptr = row + C_A + lane * 8;
    ld8(ptr, v);
    ld8(row + C_B + lane * 8, b);
#pragma unroll
    for (int i = 0; i < 8; ++i) v[i] = v[i] * sigmoidf_(b[i]);
    st8(ptr, v);
  }
}

DI void compress_item(const Params& p, int item, float* smf) {
  const int nch = item & 31; item >>= 5;
  const int g = item & 1; item >>= 1;
  const int b = item & 3; item >>= 2;
  const int which = item;
  const float* w1 = which ? p.w1_v : p.w1_k;
  const float* w2 = which ? p.w2_v : p.w2_k;
  const int col = D_KV + which * 128 + g * 64;
  const int tid = threadIdx.x, j = tid & 127, kh = tid >> 7;
  const int n0 = nch * 8;
  float acc[8];
#pragma unroll
  for (int i = 0; i < 8; ++i) acc[i] = 0.f;
  const u16* base = p.proj + (size_t)(b * SEQ) * LDP + col;
  for (int kk = 0; kk < 1024; ++kk) {
    const int k = kh * 1024 + kk, l = k >> 6, d = k & 63;
    const float wv = w1[k * 128 + j];
#pragma unroll
    for (int i = 0; i < 8; ++i) {
      int n = n0 + i; if (n > NCMP - 1) n = NCMP - 1;
      acc[i] += bf2f(base[(size_t)(16 * n + l) * LDP + d]) * wv;
    }
  }
  float* hid = smf;
  float* outb = smf + 2048;
  __syncthreads();
#pragma unroll
  for (int i = 0; i < 8; ++i) hid[(kh * 8 + i) * 128 + j] = acc[i];
  __syncthreads();
  for (int e = tid; e < 1024; e += 256) {
    float s = hid[e] + hid[1024 + e];
    for (int l = 0; l < 32; ++l) s += p.cbias[(which * 32 + l) * 128 + (e & 127)];
    hid[e] = siluf_(s);
  }
  __syncthreads();
  for (int e = tid; e < 512; e += 256) {
    const int i = e >> 6, c = e & 63;
    float a = 0.f;
    for (int jj = 0; jj < 128; ++jj) a += hid[i * 128 + jj] * w2[jj * 64 + c];
    outb[e] = a;
  }
  __syncthreads();
  const int lane = tid & 63, w = tid >> 6;
  for (int i = w; i < 8; i += 4) {
    const int n = n0 + i;
    float y = outb[i * 64 + lane];
    u16* dst = which ? (p.vcT + ((size_t)((b * 2 + g) * 64 + lane)) * 256 + n) : (p.kc + ((size_t)((b * 2 + g) * 256 + n)) * 64 + lane);
    if (n >= NCMP) { *dst = 0; continue; }
    if (which == 0) {
      float ss = wsum(y * y);
      y = y * rsqrtf(ss * (1.f / 64.f) + EPS) * p.d_knorm[lane];
      float other = __shfl_xor(y, 8);
      const float* cs = p.rope8 + (16 * n + 31) * 16;
      if (lane < 8) y = y * cs[lane] - other * cs[8 + lane];
      else if (lane < 16) y = other * cs[8 + lane - 8] + y * cs[lane - 8];
    }
    *dst = f2bf(y);
  }
}

DI void phase_prep1(const Params& p, float* smf) {
  const int lane = threadIdx.x & 63, w = threadIdx.x >> 6;
  const int n_tok = T / 4, n_cmp = 2 * 4 * 2 * 8, n_vt = 2 * 8 * 64;
  for (int it = blockIdx.x; it < n_tok + n_cmp + n_vt; it += gridDim.x) {
    if (it < n_cmp) compress_item_mfma(p, it, smf);
    else if (it < n_cmp + n_vt) {
      int e = it - n_cmp;
      const int tt = e & 63; e >>= 6;
      const int bg = e & 7; e >>= 3;
      const int which = e;
      transpose64(p.proj + (size_t)((bg >> 1) * SEQ + tt * 64) * LDP + D_KV + (which ? 5 : 3) * 128 + (bg & 1) * 64, LDP,
                  (which ? p.vwT : p.vsT) + (size_t)(bg * 64 + tt) * 4096, 64, (u16*)smf);
    }
    else prep1_token(p, (it - n_cmp - n_vt) * 4 + w, lane);
  }
}

struct OS { float m, l, acc; };
template <int DK>
DI void os_chunk(OS& st, const float* q, bool valid, const u16* krow, const u16* vbase, int vstride, float scale,
                 float* p_lds, int lane) {
  float s = -INFINITY;
  if (valid) {
    float a = 0.f;
#pragma unroll
    for (int c = 0; c < DK / 8; ++c) {
      float kv[8];
      ld8(krow + c * 8, kv);
#pragma unroll
      for (int i = 0; i < 8; ++i) a += q[c * 8 + i] * kv[i];
    }
    s = a * scale;
  }
  float cm = wmax(s);
  if (cm == -INFINITY) return;
  float mn = fmaxf(st.m, cm);
  float pe = valid ? __expf(s - mn) : 0.f;
  float corr = __expf(st.m - mn);
  st.l = st.l * corr + wsum(pe);
  st.acc *= corr;
  st.m = mn;
  wave_sync();
  p_lds[lane] = pe;
  wave_sync();
  float a = st.acc;
#pragma unroll 8
  for (int jj = 0; jj < 64; ++jj) a += p_lds[jj] * bf2f(vbase[(size_t)jj * vstride + lane]);
  st.acc = a;
}

template <int DK>
DI void load_q(const u16* ptr, float* q) {
#pragma unroll
  for (int c = 0; c < DK / 8; ++c) ld8(ptr + c * 8, q + c * 8);
}

DI void diffattn_wave(const Params& p, int b, int h, int t, float lam, float* p_lds, int lane) {
  const int tok = b * SEQ + t;
  const u16* base = p.proj + (size_t)(b * SEQ) * LDP;
  float o[2];
#pragma unroll
  for (int m = 0; m < 2; ++m) {
    float q[32];
    load_q<32>(p.proj + (size_t)tok * LDP + B_Q + (h * 2 + m) * 32, q);
    OS st{-INFINITY, 0.f, 0.f};
    const int nch = t / 64 + 1;
    for (int c = 0; c < nch; ++c) {
      const int pos = c * 64 + lane;
      os_chunk<32>(st, q, pos <= t, base + (size_t)pos * LDP + B_K + (h * 2 + m) * 32,
                   base + (size_t)(c * 64) * LDP + B_V + h * 64, LDP, 0.17677669529663687f, p_lds, lane);
    }
    o[m] = st.acc / st.l;
  }
  float od = o[0] - lam * o[1];
  float ss = wsum(od * od);
  const float lam_init = 0.8f - 0.6f * 0.7408182206817179f;
  float y = od * rsqrtf(ss * (1.f / 64.f) + EPS) * p.b_subln[lane] * (1.f - lam_init);
  float gate = bf2f(p.proj[(size_t)tok * LDP + B_G + h * 64 + lane]);
  p.ycat[(size_t)tok * MIX + 512 + h * 64 + lane] = f2bf(y * siluf_(gate));
}

DI void memattn_wave(const Params& p, int layer, int b, int h, int t, float* p_lds, int lane) {
  const int tok = b * SEQ + t;
  const int qcol = layer ? M1_Q : M0_Q, gcol = layer ? M1_G : M0_G;
  const u16* kv = (layer ? p.memkv1 : p.memkv0) + (size_t)(b * 256) * 512;
  float q[64];
  load_q<64>(p.proj + (size_t)tok * LDP + qcol + h * 64, q);
  OS st{-INFINITY, 0.f, 0.f};
  for (int c = 0; c < 4; ++c) {
    const int m = c * 64 + lane;
    os_chunk<64>(st, q, true, kv + (size_t)m * 512 + h * 64, kv + (size_t)(c * 64) * 512 + 256 + h * 64, 512, 0.125f, p_lds, lane);
  }
  float o = st.acc / st.l;
  float gate = bf2f(p.proj[(size_t)tok * LDP + gcol + h * 64 + lane]);
  p.ycat[(size_t)tok * MIX + 1024 + h * 64 + lane] = f2bf(o * siluf_(gate));
}

DI void sgu_item(const Params& p, int item, u16* smem) {
  const int g = item & 3; item >>= 2;
  const int c = item & 31; item >>= 5;
  const int b = item;
  const int tok0 = b * SEQ + c * 128;
  const int tid = threadIdx.x;
  __syncthreads();
  for (int i = tid; i < 2048; i += 256) {
    int s = i >> 4, c8 = i & 15;
    *(uint4*)(smem + s * 128 + c8 * 8) = *(const uint4*)(p.proj + (size_t)(tok0 + s) * LDP + A_V + g * 128 + c8 * 8);
  }
  __syncthreads();
  const int d = tid & 127, th = tid >> 7;
  const float* W = p.a_ws + g * 128 * 128;
  for (int t = th; t < 128; t += 2) {
    float a = 0.f;
    for (int s = 0; s <= t; ++s) a += W[t * 128 + s] * bf2f(smem[s * 128 + d]);
    float z = a + p.a_bs[g * 128 + t];
    const u16* row = p.proj + (size_t)(tok0 + t) * LDP;
    float u = geluf_(bf2f(row[A_U + g * 128 + d]));
    float gt = siluf_(bf2f(row[A_G + g * 128 + d]));
    p.ycat[(size_t)(tok0 + t) * MIX + g * 128 + d] = f2bf(u * z * gt);
  }
}

DI void phase_mix0(const Params& p, u16* smem, int* qslot) {
  const int lane = threadIdx.x & 63, w = threadIdx.x >> 6;
  float* p_lds = (float*)smem + 8192 + w * 64;
  float a1 = lane < 32 ? p.lq1[lane] * p.lk1[lane] : 0.f;
  float a2 = lane < 32 ? p.lq2[lane] * p.lk2[lane] : 0.f;
  const float lam_init = 0.8f - 0.6f * 0.7408182206817179f;
  const float lam = expf(wsum(a1)) - expf(wsum(a2)) + lam_init;
  const int n_diff = BATCH * 8 * 32, n_sgu = BATCH * 32 * 4, n_mem = BATCH * 4 * 32;
  const int G = gridDim.x;
  (void)G;
  unsigned* ctr = p.qctr;
  int it = blockIdx.x;
  while (it < n_diff) {
    const int qt = 31 - it / 32, bh = it % 32;
    diffattn_item(p, bh >> 3, bh & 7, qt, lam, smem);
    it = queue_pull(ctr, qslot);
  }
  while (it < n_diff + n_sgu) { sgu_item_mfma(p, it - n_diff, smem); it = queue_pull(ctr, qslot); }
  while (it < n_diff + n_sgu + n_mem) {
    const int e = it - n_diff - n_sgu;
    memattn_item(p, 0, (e >> 2) & 3, e & 3, e >> 4, smem);
    it = queue_pull(ctr, qslot);
  }
}

DI void conv_item(const Params& p, int item, float* smf) {
  const int tt = item & 255, b = item >> 8;
  const int t0 = tt * 16, tid = threadIdx.x;
  const u16* base = p.proj + (size_t)(b * SEQ) * LDP + C_A;
  __syncthreads();
#pragma unroll 1
  for (int cc = 0; cc < 2; ++cc) {
    const int c = tid + cc * 256;
    float wv[31];
#pragma unroll
    for (int j = 0; j < 31; ++j) wv[j] = p.conv_w[j * 512 + c];
    const float bias = p.conv_b[c];
#pragma unroll 1
    for (int i = 0; i < 16; ++i) {
      const int t = t0 + i;
      float a = bias;
#pragma unroll
      for (int j = 0; j < 31; ++j) {
        int ts = t - 30 + j;
        float hv = ts >= 0 ? bf2f(base[(size_t)ts * LDP + c]) : 0.f;
        a += hv * wv[j];
      }
      smf[i * 512 + c] = a;
    }
  }
  __syncthreads();
  const int lane = tid & 63, w = tid >> 6;
  for (int i = w; i < 16; i += 4) {
    const int tok = b * SEQ + t0 + i;
    float v[8], ss = 0.f;
#pragma unroll
    for (int e = 0; e < 8; ++e) { v[e] = smf[i * 512 + e * 64 + lane]; ss += v[e] * v[e]; }
    ss = wsum(ss);
    float rs = rsqrtf(ss * (1.f / 512.f) + EPS);
#pragma unroll
    for (int e = 0; e < 8; ++e) {
      int c = e * 64 + lane;
      float y = siluf_(v[e] * rs * p.c_norm[c]);
      float gt = siluf_(bf2f(p.proj[(size_t)tok * LDP + C_G + c]));
      p.ycat[(size_t)tok * MIX + c] = f2bf(y * gt);
    }
  }
}

DI void nsa_wave(const Params& p, int b, int t, int g, float* wl  , int lane) {
  const int tok = b * SEQ + t;
  const u16* prow = p.proj + (size_t)tok * LDP;
  const u16* base = p.proj + (size_t)(b * SEQ) * LDP;
  const u16* kcb = p.kc + (size_t)((b * 2 + g) * 256) * 64;
  const u16* vcb = p.vc + (size_t)((b * 2 + g) * 256) * 64;
  float* p_lds = wl;
  float* ps_lds = wl + 64;
  float psum[4] = {0.f, 0.f, 0.f, 0.f};
  float oc[4];
  const int nvc = t >= 31 ? min((t - 31) / 16 + 1, NCMP) : 0;
  oc[0] = oc[1] = oc[2] = oc[3] = 0.f;
#pragma unroll 1
  for (int r = 0; r < 4; ++r) {
    const int h = g * 4 + r;
    float q[64];
    load_q<64>(prow + D_Q + h * 64, q);
    float s[4] = {-INFINITY, -INFINITY, -INFINITY, -INFINITY};
    float mx = -INFINITY;
#pragma unroll 1
    for (int i = 0; i < 4; ++i) {
      const int n = lane + 64 * i;
      float sv = -INFINITY;
      if (n < nvc) {
        float a = 0.f;
#pragma unroll
        for (int c = 0; c < 8; ++c) {
          float kv[8];
          ld8(kcb + n * 64 + c * 8, kv);
#pragma unroll
          for (int e = 0; e < 8; ++e) a += q[c * 8 + e] * kv[e];
        }
        sv = a * 0.125f;
      }
      if (i == 0) s[0] = sv; else if (i == 1) s[1] = sv; else if (i == 2) s[2] = sv; else s[3] = sv;
      mx = fmaxf(mx, sv);
    }
    mx = wmax(mx);
    float e4[4], sum = 0.f;
#pragma unroll
    for (int i = 0; i < 4; ++i) { e4[i] = (s[i] > -INFINITY) ? __expf(s[i] - mx) : 0.f; sum += e4[i]; }
    sum = wsum(sum);
    const float inv = 1.f / fmaxf(sum, 1.17549435e-38f);
    float acc = 0.f;
#pragma unroll
    for (int i = 0; i < 4; ++i) {
      const float pr = e4[i] * inv;
      psum[i] += pr;
      if (i * 64 < nvc) {
        wave_sync();
        p_lds[lane] = pr;
        wave_sync();
        for (int jj = 0; jj < 64; ++jj) acc += p_lds[jj] * bf2f(vcb[(size_t)(i * 64 + jj) * 64 + lane]);
      }
    }
    if (r == 0) oc[0] = acc; else if (r == 1) oc[1] = acc; else if (r == 2) oc[2] = acc; else oc[3] = acc;
  }
  wave_sync();
#pragma unroll
  for (int i = 0; i < 4; ++i) ps_lds[lane + 64 * i] = psum[i];
  wave_sync();
  float imp = ps_lds[4 * lane] + ps_lds[4 * lane + 1] + ps_lds[4 * lane + 2] + 0.5f * ps_lds[4 * lane + 3];
  if (lane > 0) imp += 0.5f * ps_lds[4 * lane - 1];
  const int cur = t >> 6;
  if (lane > cur) imp = -INFINITY;
  if (lane == 0 || lane == cur || lane == cur - 1) imp = INFINITY;
  int cnt = 0;
  for (int jj = 0; jj < 64; ++jj) {
    float v = __shfl(imp, jj);
    cnt += (v > imp || (v == imp && jj < lane)) ? 1 : 0;
  }
  u64 msk = __ballot(cnt < 16 && lane <= cur);
#pragma unroll 1
  for (int r = 0; r < 4; ++r) {
    const int h = g * 4 + r;
    float q[64];
    load_q<64>(prow + D_Q + h * 64, q);
    OS ss{-INFINITY, 0.f, 0.f};
    u64 mm = msk;
    while (mm) {
      const int j = __ffsll((long long)mm) - 1; mm &= mm - 1;
      const int pos = j * 64 + lane;
      os_chunk<64>(ss, q, pos <= t, base + (size_t)pos * LDP + D_KV + 2 * 128 + g * 64,
                   base + (size_t)(j * 64) * LDP + D_KV + 3 * 128 + g * 64, LDP, 0.125f, p_lds, lane);
    }
    const float o_s = ss.l > 0.f ? ss.acc / ss.l : 0.f;
    OS sw{-INFINITY, 0.f, 0.f};
    const int lo = max(t - 511, 0);
    for (int c = lo >> 6; c <= cur; ++c) {
      const int pos = c * 64 + lane;
      os_chunk<64>(sw, q, pos <= t && pos >= lo, base + (size_t)pos * LDP + D_KV + 4 * 128 + g * 64,
                   base + (size_t)(c * 64) * LDP + D_KV + 5 * 128 + g * 64, LDP, 0.125f, p_lds, lane);
    }
    const float o_w = sw.l > 0.f ? sw.acc / sw.l : 0.f;
    const float gc = sigmoidf_(bf2f(prow[D_BG + h * 3 + 0]));
    const float gs = sigmoidf_(bf2f(prow[D_BG + h * 3 + 1]));
    const float gw = sigmoidf_(bf2f(prow[D_BG + h * 3 + 2]));
    const float ocr = r == 0 ? oc[0] : r == 1 ? oc[1] : r == 2 ? oc[2] : oc[3];
    const float o = gc * ocr + gs * o_s + gw * o_w;
    const float gate = bf2f(prow[D_G + h * 64 + lane]);
    p.ycat[(size_t)tok * MIX + 512 + h * 64 + lane] = f2bf(o * siluf_(gate));
  }
}

DI void nsa_item(const Params& p, int b, int g, int qt, u16* smem) {
  const int lane = threadIdx.x & 63, w = threadIdx.x >> 6, l31 = lane & 31, hh = lane >> 5;
  const int q0 = qt * 32, wq0 = q0 + 8 * w, qi = l31 & 7, myq = wq0 + qi;
  const int h = g * 4 + (l31 >> 3);
  const size_t tok = (size_t)b * SEQ + myq;
  const u16* prow = p.proj + tok * LDP;
  float* impW = (float*)(smem + 2 * KV_BUF) + w * (8 * 65);
  u64* Ush = (u64*)((float*)(smem + 2 * KV_BUF) + 4 * 8 * 65);
  bf16x8 qf[4];
#pragma unroll
  for (int ks = 0; ks < 4; ++ks) qf[ks] = *(const bf16x8*)(prow + D_Q + h * 64 + ks * 16 + hh * 8);
  const float c = 0.125f * 1.4426950408889634f;
#pragma unroll
  for (int ks = 0; ks < 4; ++ks) qf[ks] = scale_frag(qf[ks], c);
  const bf16x8 aone = frag_first(1.f, hh);
  const bf16x8 qx = frag_first(-8.f * 1.01f * gain_absmax(p.d_knorm, 64, lane) * sqrtf(q_norm2<4>(qf)), hh);
  const bf16x8 qxoff = frag_first(-INFINITY, hh);
  const u16 gate_c = prow[D_BG + h * 3 + 0], gate_s = prow[D_BG + h * 3 + 1], gate_w = prow[D_BG + h * 3 + 2];
  f32x16 outacc[2];
  const u16* kcb = p.kc + (size_t)((b * 2 + g) * 256) * 64;
  const u16* vctb = p.vcT + (size_t)((b * 2 + g) * 64) * 256;
  const int hi_c = (myq >= 31) ? ((myq - 31) >> 4) : -1;
  const int hi_c_min = (wq0 >= 31) ? ((wq0 - 31) >> 4) : -1;
  const int nct = (q0 >> 10) + 1;
  float l1 = 0.f;
  kv_pipeline(nct, smem,
    [&](int j, const u16*& kp, int& ks, const u16*& vp, int& vs) { kp = kcb + (size_t)(j * 64) * 64; ks = 64; vp = vctb + j * 64; vs = 256; },
    [&](int j, const u16* Ks, const u16* Vt) {
      f32x16 s[2];
      fa_scores<64>(s, qf, Ks, l31, hh, aone, qx);
      if (j * 64 + 63 > hi_c_min) fa_mask(s, j * 64, 0, hi_c, hh);
      float rs = 0.f;
#pragma unroll
      for (int sub = 0; sub < 2; ++sub)
#pragma unroll
        for (int i = 0; i < 16; ++i) rs += __builtin_amdgcn_exp2f(s[sub][i]);
      l1 += rs;
    });
  l1 += __shfl_xor(l1, 32);
  {
    FAState stc; fa_init(stc);
    const float il = l1 > 0.f ? 1.f / l1 : 0.f;
    float prevy = 0.f;
    kv_pipeline(nct, smem,
      [&](int j, const u16*& kp, int& ks, const u16*& vp, int& vs) { kp = kcb + (size_t)(j * 64) * 64; ks = 64; vp = vctb + j * 64; vs = 256; },
      [&](int j, const u16* Ks, const u16* Vt) {
        f32x16 s[2];
        fa_scores<64>(s, qf, Ks, l31, hh, aone, qx);
        if (j * 64 + 63 > hi_c_min) fa_mask(s, j * 64, 0, hi_c, hh);
#pragma unroll
        for (int sub = 0; sub < 2; ++sub)
#pragma unroll
          for (int i = 0; i < 16; ++i) s[sub][i] = __builtin_amdgcn_exp2f(s[sub][i]) * il;
        bf16x8 pf[4];
#pragma unroll
        for (int ks = 0; ks < 4; ++ks) pf[ks] = pack8(s[ks >> 1], (ks & 1) * 8);
        fa_pv(stc, pf, Vt, l31, hh);
#pragma unroll
        for (int a = 0; a < 8; ++a) {
          const int sub = a >> 2, r4 = (a & 3) * 4;
          const float p3 = s[sub][r4 + 3];
          const float y = __shfl_xor(p3, 32);
          float A = s[sub][r4] + s[sub][r4 + 1] + s[sub][r4 + 2] + 0.5f * p3 + 0.5f * (hh ? y : prevy);
          prevy = y;
          A += __shfl_xor(A, 8);
          A += __shfl_xor(A, 16);
          if (l31 < 8) impW[qi * 65 + 16 * j + 2 * a + hh] = A;
        }
      });
    const float gc = sigmoidf_(bf2f(gate_c));
#pragma unroll
    for (int i = 0; i < 16; ++i) { outacc[0][i] = gc * stc.o[0][i]; outacc[1][i] = gc * stc.o[1][i]; }
  }
  wave_sync();
  u64 mymsk = 0, Uw = 0;
#pragma unroll 1
  for (int q8 = 0; q8 < 8; ++q8) {
    const int cur = (wq0 + q8) >> 6;
    float imp = impW[q8 * 65 + lane];
    if (lane == 0 || lane == cur || lane == cur - 1) imp = INFINITY;
    unsigned key = (__float_as_uint(imp) & ~63u) | (unsigned)(63 - lane);
    if (lane > cur) key = 0u;
    int cnt = 0;
#pragma unroll 16
    for (int jj = 0; jj < 64; ++jj) {
      const unsigned kv = (unsigned)__builtin_amdgcn_readlane((int)key, jj);
      cnt += (kv > key) ? 1 : 0;
    }
    const u64 bal = __ballot(cnt < 16 && lane <= cur);
    if (qi == q8) mymsk = bal;
    Uw |= bal;
  }
  __syncthreads();
  if (lane == 0) Ush[w] = Uw;
  __syncthreads();
  const u64 Ub = Ush[0] | Ush[1] | Ush[2] | Ush[3];
  {
    FAState st; fa_init(st);
    const u16* vtb = p.vsT + (size_t)(b * 2 + g) * SEQ * 64;
    const u16* kb2 = p.proj + (size_t)(b * SEQ) * LDP + D_KV + 256 + g * 64;
    u64 remL = Ub, remC = Ub;
    kv_pipeline(__popcll(Ub), smem,
      [&](int t, const u16*& kp, int& ks, const u16*& vp, int& vs) {
        const int j = __ffsll((long long)remL) - 1; remL &= remL - 1;
        kp = kb2 + (size_t)(j * 64) * LDP; ks = LDP; vp = vtb + (size_t)j * 4096; vs = 64; },
      [&](int t, const u16* Ks, const u16* Vt) {
        const int j = __ffsll((long long)remC) - 1; remC &= remC - 1;
        if ((Uw >> j) & 1) {
          f32x16 s[2];
          fa_scores<64>(s, qf, Ks, l31, hh, aone, ((mymsk >> j) & 1) ? qx : qxoff);
          if (j * 64 + 63 > wq0) fa_mask(s, j * 64, 0, myq, hh);
          fa_softmax_pv(st, s, Vt, l31, hh);
        }
      });
    const float gs = sigmoidf_(bf2f(gate_s));
    const float ls = fa_rowsum(st);
    const float f = ls > 0.f ? gs / ls : 0.f;
#pragma unroll
    for (int i = 0; i < 16; ++i) { outacc[0][i] += f * st.o[0][i]; outacc[1][i] += f * st.o[1][i]; }
  }
  {
    FAState st; fa_init(st);
    const u16* vtb = p.vwT + (size_t)(b * 2 + g) * SEQ * 64;
    const u16* kb2 = p.proj + (size_t)(b * SEQ) * LDP + D_KV + 512 + g * 64;
    const int jlo = max(q0 - 511, 0) >> 6, jhi = (q0 + 31) >> 6;
    kv_pipeline(jhi - jlo + 1, smem,
      [&](int t, const u16*& kp, int& ks, const u16*& vp, int& vs) {
        const int j = jlo + t;
        kp = kb2 + (size_t)(j * 64) * LDP; ks = LDP; vp = vtb + (size_t)j * 4096; vs = 64; },
      [&](int t, const u16* Ks, const u16* Vt) {
        const int k0 = (jlo + t) * 64;
        if (k0 <= wq0 + 7 && k0 + 63 >= wq0 - 511) {
          f32x16 s[2];
          fa_scores<64>(s, qf, Ks, l31, hh, aone, qx);
          const bool need_mask = !(k0 >= wq0 + 7 - 511 && k0 + 63 <= wq0);
          if (need_mask) fa_mask(s, k0, myq - 511, myq, hh);
          fa_softmax_pv(st, s, Vt, l31, hh);
        }
      });
    const float gw = sigmoidf_(bf2f(gate_w));
    const float lw = fa_rowsum(st);
    const float f = lw > 0.f ? gw / lw : 0.f;
#pragma unroll
    for (int i = 0; i < 16; ++i) { outacc[0][i] += f * st.o[0][i]; outacc[1][i] += f * st.o[1][i]; }
  }
  uint2 gqs[2][4];
#pragma unroll
  for (int d = 0; d < 2; ++d)
#pragma unroll
    for (int a = 0; a < 4; ++a) gqs[d][a] = *(const uint2*)(prow + D_G + h * 64 + d * 32 + 8 * a + 4 * hh);
#pragma unroll
  for (int d = 0; d < 2; ++d)
#pragma unroll
    for (int a = 0; a < 4; ++a) {
      const int dim = d * 32 + 8 * a + 4 * hh;
      uint2 gq = gqs[d][a];
      float g0 = __uint_as_float(gq.x << 16), g1 = __uint_as_float(gq.x & 0xffff0000u);
      float g2 = __uint_as_float(gq.y << 16), g3 = __uint_as_float(gq.y & 0xffff0000u);
      uint2 o;
      o.x = pk_bf16(outacc[d][4 * a + 0] * siluf_(g0), outacc[d][4 * a + 1] * siluf_(g1));
      o.y = pk_bf16(outacc[d][4 * a + 2] * siluf_(g2), outacc[d][4 * a + 3] * siluf_(g3));
      *(uint2*)(p.ycat + tok * MIX + 512 + h * 64 + dim) = o;
    }
}

DI void phase_mix1(const Params& p, float* smf) {
  const int n_nsa = BATCH * 2 * 128, n_conv = BATCH * 256, n_mem = BATCH * 4 * 32;
  const int G = gridDim.x;
  const int total = n_nsa + n_conv + n_mem;
  const int total_r = ((total + G - 1) / G) * G;
  for (int it0 = blockIdx.x; it0 < total_r; it0 += G) {
    const int rnd = it0 / G;
    const int it = (rnd & 1) ? (rnd * G + (G - 1 - (it0 - rnd * G))) : it0;
    if (it >= total) continue;
    if (it < n_nsa) {
      const int qt = 127 - it / 8, bg = it % 8;
      nsa_item(p, bg >> 1, bg & 1, qt, (u16*)smf);
    } else if (it < n_nsa + n_conv) {
      conv_item2(p, it - n_nsa, smf);
    } else {
      const int e = it - n_nsa - n_conv;
      memattn_item(p, 1, (e >> 2) & 3, e & 3, e >> 4, (u16*)smf);
    }
  }
}

enum { K_PLAIN = 0, K_N32R4, K_GELU_N128, K_N64, K_N64R8, K_VT, K_VTM };
constexpr int CLD = 136;

DI void gemm_tile_fused(const u16* __restrict__ A, int lda, const u16* __restrict__ Bt, int ldb, int K, int m0, int n0, u16* smem,
                        int kind, u16* base, int ldc, int hb, int hbase, const float* gain, const Params& p) {
  const int tid = threadIdx.x, lane = tid & 63, w = tid >> 6;
  const int wm = w >> 1, wn = w & 1, l31 = lane & 31, hh = lane >> 5;
  f32x16 acc[2][2];
  gemm_mainloop(acc, A, lda, Bt, ldb, K, m0, n0, smem);
  u16* Ct = smem;
  __syncthreads();
#pragma unroll
  for (int i = 0; i < 2; ++i)
#pragma unroll
    for (int j = 0; j < 2; ++j)
#pragma unroll
      for (int r = 0; r < 16; ++r)
        Ct[(wm * 64 + i * 32 + (r & 3) + 8 * (r >> 2) + 4 * hh) * CLD + wn * 64 + j * 32 + l31] = f2bf(acc[i][j][r]);
  __syncthreads();
  if (kind == K_VT || kind == K_VTM) {
    const int d = tid >> 2, tc = tid & 3;
#pragma unroll 1
    for (int blk = 0; blk < 4; ++blk) {
      const int hsub = blk >> 1, tsub = blk & 1;
      unsigned u[8];
#pragma unroll
      for (int i = 0; i < 8; ++i)
        u[i] = (unsigned)Ct[(tsub * 64 + tc * 16 + 2 * i) * CLD + hsub * 64 + d] |
               ((unsigned)Ct[(tsub * 64 + tc * 16 + 2 * i + 1) * CLD + hsub * 64 + d] << 16);
      u16* dst;
      if (kind == K_VT) {
        const int b = m0 >> 12, tt = ((m0 & 4095) >> 6) + tsub;
        dst = base + ((size_t)((b * hb + hbase + hsub) * 64 + tt)) * 4096 + d * 64 + tc * 16;
      } else {
        const int b = m0 >> 8, mo = (m0 & 255) + tsub * 64;
        dst = base + ((size_t)((b * 4 + hbase + hsub) * 64 + d)) * 256 + mo + tc * 16;
      }
      u32x4 a = {u[0], u[1], u[4], u[5]}, bq = {u[2], u[3], u[6], u[7]};
      *(u32x4*)dst = a;
      *(u32x4*)(dst + 8) = bq;
    }
    return;
  }
  const int l16 = tid & 15, c8 = l16 * 8;
  float gn[8];
  {
    const int gi = (kind == K_N32R4) ? (l16 & 3) * 8 : (kind == K_GELU_N128) ? c8 : (l16 & 7) * 8;
#pragma unroll
    for (int i = 0; i < 8; ++i) gn[i] = (kind == K_PLAIN) ? 1.f : gain[gi + i];
  }
  const int r0 = tid >> 4;
  if (kind == K_PLAIN) {
#pragma unroll
    for (int ps = 0; ps < 8; ++ps) {
      const int row = ps * 16 + r0;
      *(u32x4*)(base + (size_t)(m0 + row) * ldc + n0 + c8) = *(const u32x4*)(Ct + row * CLD + c8);
    }
    return;
  }
  if (kind == K_N32R4) {
#pragma unroll
    for (int ps = 0; ps < 8; ++ps) {
      const int row = ps * 16 + r0, grow = m0 + row, t = grow & (SEQ - 1);
      float v[8];
      ld8(Ct + row * CLD + c8, v);
      const float4 cs0 = *(const float4*)(p.rope4 + t * 8), cs1 = *(const float4*)(p.rope4 + t * 8 + 4);
      const float rs = group_rs<4>(v);
#pragma unroll
      for (int i = 0; i < 8; ++i) v[i] = v[i] * rs * gn[i];
      if ((l16 & 3) == 0) {
        const float cc[4] = {cs0.x, cs0.y, cs0.z, cs0.w}, sn[4] = {cs1.x, cs1.y, cs1.z, cs1.w};
#pragma unroll
        for (int i = 0; i < 4; ++i) {
          float x1 = v[i], x2 = v[4 + i];
          v[i] = x1 * cc[i] - x2 * sn[i]; v[4 + i] = x1 * sn[i] + x2 * cc[i];
        }
      }
      st8(base + (size_t)grow * ldc + n0 + c8, v);
    }
    return;
  }
  if (kind == K_GELU_N128) {
#pragma unroll
    for (int ps = 0; ps < 8; ++ps) {
      const int row = ps * 16 + r0, grow = m0 + row;
      float v[8];
      ld8(Ct + row * CLD + c8, v);
#pragma unroll
      for (int i = 0; i < 8; ++i) v[i] = geluf_(v[i]);
      const float rs = group_rs<16>(v);
#pragma unroll
      for (int i = 0; i < 8; ++i) v[i] = v[i] * rs * gn[i];
      st8(base + (size_t)grow * ldc + n0 + c8, v);
    }
    return;
  }
  {
    const int sub = l16 & 7;
#pragma unroll
    for (int ps = 0; ps < 8; ++ps) {
      const int row = ps * 16 + r0, grow = m0 + row, t = grow & (SEQ - 1);
      float v[8];
      ld8(Ct + row * CLD + c8, v);
      float4 c0, c1, s0, s1;
      if (kind == K_N64R8) {
        c0 = *(const float4*)(p.rope8 + t * 16); c1 = *(const float4*)(p.rope8 + t * 16 + 4);
        s0 = *(const float4*)(p.rope8 + t * 16 + 8); s1 = *(const float4*)(p.rope8 + t * 16 + 12);
      }
      const float rs = group_rs<8>(v);
#pragma unroll
      for (int i = 0; i < 8; ++i) v[i] = v[i] * rs * gn[i];
      if (kind == K_N64R8) {
        const float cc[8] = {c0.x, c0.y, c0.z, c0.w, c1.x, c1.y, c1.z, c1.w};
        const float sn[8] = {s0.x, s0.y, s0.z, s0.w, s1.x, s1.y, s1.z, s1.w};
#pragma unroll
        for (int i = 0; i < 8; ++i) {
          const float other = __shfl_xor(v[i], 1);
          if (sub == 0) v[i] = v[i] * cc[i] - other * sn[i];
          else if (sub == 1) v[i] = other * sn[i] + v[i] * cc[i];
        }
      }
      st8(base + (size_t)grow * ldc + n0 + c8, v);
    }
  }
}

DI void phase_gemm_in2(const Params& p, int layer, u16* smem) {
  const u16* Bt = layer ? p.winT1 : p.winT0;
  const int ntn = layer ? 31 : 32;
  const int main_items = (T / 128) * ntn;
  const int extra = layer ? 0 : 2 * 8 * 4;
  for (int it = blockIdx.x; it < main_items + extra; it += gridDim.x) {
    if (it < main_items) {
      const int mt = it / ntn;
      const int nt = layer ? (it % ntn) : ((it % ntn) + 4 * (mt >> 4)) & 31;
      const int n0 = nt * 128;
      int kind = K_PLAIN, hb = 0, hbase = 0; u16* base = p.proj; const float* gain = nullptr;
      if (!layer) {
        if (n0 >= A_V && n0 < A_G) { kind = K_GELU_N128; gain = p.a_vnorm + (n0 - A_V); }
        else if (n0 >= B_Q && n0 < B_K) { kind = K_N32R4; gain = p.b_qnorm; }
        else if (n0 >= B_K && n0 < B_V) { kind = K_N32R4; gain = p.b_knorm; }
        else if (n0 >= B_V && n0 < B_G) { kind = K_VT; base = p.vT; hb = 8; hbase = (n0 - B_V) >> 6; }
        else if (n0 >= M0_Q && n0 < M0_G) { kind = K_N64; gain = p.m0_qnorm; }
      } else {
        if (n0 >= D_Q && n0 < D_KV) { kind = K_N64R8; gain = p.d_qnorm; }
        else if (n0 == D_KV + 256) { kind = K_N64R8; gain = p.d_knorm; }
        else if (n0 == D_KV + 384) { kind = K_VT; base = p.vsT; hb = 2; }
        else if (n0 == D_KV + 512) { kind = K_N64R8; gain = p.d_knorm; }
        else if (n0 == D_KV + 640) { kind = K_VT; base = p.vwT; hb = 2; }
        else if (n0 >= M1_Q && n0 < M1_G) { kind = K_N64; gain = p.m1_qnorm; }
      }
      gemm_tile_fused(p.h, 1024, Bt, 1024, 1024, mt * 128, n0, smem, kind, base, LDP, hb, hbase, gain, p);
    } else {
      const int e = it - main_items;
      const int l = e / 32, r = e % 32, mt = r / 4, nt = r % 4, n0 = nt * 128;
      u16* kvb = l ? p.memkv1 : p.memkv0;
      if (n0 < 256) gemm_tile_fused(p.memn, 1024, l ? p.wkvT1 : p.wkvT0, 1024, 1024, mt * 128, n0, smem, K_N64, kvb, 512, 0, 0, l ? p.m1_knorm : p.m0_knorm, p);
      else gemm_tile_fused(p.memn, 1024, l ? p.wkvT1 : p.wkvT0, 1024, 1024, mt * 128, n0, smem, K_VTM, l ? p.memvT1 : p.memvT0, 512, 0, (n0 - 256) >> 6, nullptr, p);
    }
  }
}

DI void phase_mid1(const Params& p, float* smf, int* qslot) {
  const int n_cmp = 2 * 4 * 2 * 8, n_conv = BATCH * 256, n_mem = BATCH * 4 * 32;
  unsigned* ctr = p.qctr + 32;
  int it = blockIdx.x;
  while (it < n_cmp) { compress_item_mfma(p, it, smf); it = queue_pull(ctr, qslot); }
  while (it < n_cmp + n_conv) { conv_item4(p, it - n_cmp, smf); it = queue_pull(ctr, qslot); }
  while (it < n_cmp + n_conv + n_mem) {
    const int e = it - n_cmp - n_conv;
    memattn_item(p, 1, (e >> 2) & 3, e & 3, e >> 4, (u16*)smf);
    it = queue_pull(ctr, qslot);
  }
}
#ifndef PROBE_MID
#define PROBE_MID 0
#endif
DI void phase_probe_mid(const Params& p, float* smf) {
  const int n_cmp = 2 * 4 * 2 * 8, n_conv = BATCH * 256, n_mem = BATCH * 4 * 32;
  if (PROBE_MID == 1) for (int it = blockIdx.x; it < n_cmp; it += gridDim.x) compress_item_mfma(p, it, smf);
  if (PROBE_MID == 2) for (int it = blockIdx.x; it < n_conv; it += gridDim.x) conv_item2(p, it, smf);
  if (PROBE_MID == 3) for (int e = blockIdx.x; e < n_mem; e += gridDim.x) memattn_item(p, 1, (e >> 2) & 3, e & 3, e >> 4, (u16*)smf);
}
DI void phase_nsa(const Params& p, float* smf, int* qslot) {
  const int n_nsa = BATCH * 2 * 128;
  int it = blockIdx.x;
  while (it < n_nsa) {
    const int qt = 127 - it / 8, bg = it % 8;
    nsa_item(p, bg >> 1, bg & 1, qt, (u16*)smf);
    it = queue_pull(p.qctr + 16, qslot);
  }
}

DI void phase_norm1(const Params& p) {
  const int lane = threadIdx.x & 63, w = threadIdx.x >> 6;
  for (int it = blockIdx.x; it < T / 4; it += gridDim.x) {
    int row = it * 4 + w;
    rmsnorm_row(p.out + (size_t)row * 1024, p.l1_norm, p.h + (size_t)row * 1024, lane);
  }
}

#define XB_TMO      128
#define XB_XCNT(j)  (256  + 64 * (j))
#define XB_XSUB(j)  (1280 + 64 * (j))
#define XB_XGEN(j)  (2304 + 64 * (j))
#define XB_TOP      3328
#define XB_TOPGEN   3392
#define XCD_BAR_WORDS 3456
#define XB_SPIN_CAP (1u << 18)
#define LAS __attribute__((address_space(3)))

__device__ __forceinline__ unsigned xb_ld(unsigned* p)              { return __hip_atomic_load(p, __ATOMIC_RELAXED, __HIP_MEMORY_SCOPE_AGENT); }
__device__ __forceinline__ unsigned xb_add(unsigned* p, unsigned v) { return __hip_atomic_fetch_add(p, v, __ATOMIC_RELAXED, __HIP_MEMORY_SCOPE_AGENT); }
__device__ __forceinline__ unsigned xb_xcc_id() { return (unsigned)__builtin_amdgcn_s_getreg((3 << 11) | 20) & 0xFu; }
#define XB_SPIN(cond, bar) do { unsigned _sp = 0; while (cond) { __builtin_amdgcn_s_sleep(1); \
    if ((++_sp & 255u) == 0u) { if (xb_ld(&(bar)[XB_TMO])) break; if (_sp > XB_SPIN_CAP) { atomicAdd(&(bar)[XB_TMO], 1u); break; } } } } while (0)

struct XcdBarrier {
    unsigned* bar; unsigned x;
    volatile LAS unsigned* st;
};

__device__ __forceinline__ XcdBarrier xcd_barrier_post(unsigned* bar, volatile LAS unsigned* st) {
    XcdBarrier b; b.bar = bar; b.x = xb_xcc_id(); b.st = st;
    if (threadIdx.x == 0) (void)xb_add(&bar[XB_XCNT(b.x)], 1u);
    return b;
}
__device__ __forceinline__ void xcd_barrier_complete(unsigned* bar, unsigned x, unsigned& nloc, unsigned& nx) {
    const unsigned G = gridDim.x * gridDim.y * gridDim.z;
    unsigned sum, cnt, mine, sp = 0u;
    for (;;) {
        sum = 0u; cnt = 0u; mine = 0u;
#pragma unroll
        for (unsigned j = 0; j < 16; ++j) { const unsigned c = xb_ld(&bar[XB_XCNT(j)]); sum += c; cnt += (c > 0u) ? 1u : 0u; mine = (j == x) ? c : mine; }
        if (sum == G) break;
        __builtin_amdgcn_s_sleep(1);
        if ((++sp & 255u) == 0u) { if (xb_ld(&bar[XB_TMO])) break; if (sp > XB_SPIN_CAP) { atomicAdd(&bar[XB_TMO], 1u); break; } }
    }
    nloc = mine > 0u ? mine : 1u; nx = cnt > 0u ? cnt : 1u;
}

__device__ __forceinline__ void xcd_barrier(const XcdBarrier& b) {
    asm volatile("s_waitcnt vmcnt(0)" ::: "memory");
    __syncthreads();
    if (threadIdx.x == 0) {
        unsigned* bar = b.bar;
        __builtin_amdgcn_s_waitcnt(0);
        unsigned nloc = b.st[0], nx = b.st[1];
        if (nloc == 0u) { xcd_barrier_complete(bar, b.x, nloc, nx); b.st[0] = nloc; b.st[1] = nx; }
        const unsigned old = xb_add(&bar[XB_XSUB(b.x)], 1u);
        const unsigned gen = old / nloc;
        if (old + 1u == (gen + 1u) * nloc) {
            __builtin_amdgcn_fence(__ATOMIC_RELEASE, "agent");
            asm volatile("s_waitcnt vmcnt(0)" ::: "memory");
            const unsigned og = xb_add(&bar[XB_TOP], 1u);
            const unsigned tg = og / nx;
            if (og + 1u == (tg + 1u) * nx) xb_add(&bar[XB_TOPGEN], 1u);
            else XB_SPIN(xb_ld(&bar[XB_TOPGEN]) == tg, bar);
            __builtin_amdgcn_fence(__ATOMIC_ACQUIRE, "agent");
            xb_add(&bar[XB_XGEN(b.x)], 1u);
            asm volatile("s_waitcnt vmcnt(0)" ::: "memory");
        } else {
            XB_SPIN(xb_ld(&bar[XB_XGEN(b.x)]) == gen, bar);
            __builtin_amdgcn_fence(__ATOMIC_ACQUIRE, "agent");
            asm volatile("s_waitcnt vmcnt(0)" ::: "memory");
        }
    }
    __syncthreads();
}

constexpr int NPHASE = 9;
#ifndef PHMASK
#define PHMASK 0x3ff
#endif
constexpr int LDS_BYTES = 45568;

__global__ void __launch_bounds__(256, 2) mega(Params p, int ph_lo, int ph_hi) {
  __shared__ __attribute__((aligned(16))) unsigned char smem_raw[LDS_BYTES];
  u16* smem = (u16*)smem_raw;
  float* smf = (float*)smem_raw;
#ifndef DUPMASK
#define DUPMASK 0
#endif
#define RUN_PHASE(n, call) if (ph_lo <= n && n < ph_hi) { if (PHMASK & (1 << n)) { call; } if (DUPMASK & (1 << n)) { __syncthreads(); call; } if (n + 1 < ph_hi) { xcd_barrier(xb); } }
  __shared__ uint4 xb_words;
  __shared__ int qslot;
  if (threadIdx.x == 0) xb_words = make_uint4(0u, 0u, 0u, 0u);
  __syncthreads();
  XcdBarrier xb = xcd_barrier_post(p.bar, (volatile LAS unsigned*)&xb_words);
  if (ph_hi > 1000) cg::this_grid().sync();
  RUN_PHASE(0, phase0(p, smf))
  RUN_PHASE(1, phase_gemm_in2(p, 0, smem))
  RUN_PHASE(2, phase_mix0(p, smem, &qslot))
  RUN_PHASE(3, phase_gemm_out(p, 0, smem))
  RUN_PHASE(4, phase_norm1(p))
  RUN_PHASE(5, phase_gemm_in2(p, 1, smem))
  RUN_PHASE(6, phase_mid1(p, smf, &qslot))
  RUN_PHASE(7, phase_nsa(p, smf, &qslot))
  RUN_PHASE(8, phase_gemm_out(p, 1, smem))
}

#ifndef ONE_LAUNCH
#define ONE_LAUNCH 1
#endif

extern "C" void kernel_launch(void* const* d_in, const int* in_sizes, int n_in, void* d_out, int out_size, void* d_ws,
                              size_t ws_size, hipStream_t stream) {
  Params p{};
  const float* const* in = (const float* const*)d_in;
  p.x = in[0]; p.mem = in[1]; p.mem_norm = in[2];
  p.l0_norm = in[3]; p.l0_w_in = in[4]; p.a_vnorm = in[5]; p.a_ws = in[6]; p.a_bs = in[7]; p.b_qnorm = in[8]; p.b_knorm = in[9];
  p.lq1 = in[10]; p.lk1 = in[11]; p.lq2 = in[12]; p.lk2 = in[13]; p.b_subln = in[14];
  p.m0_wkv = in[15]; p.m0_qnorm = in[16]; p.m0_knorm = in[17]; p.l0_w_out = in[18];
  p.l1_norm = in[19]; p.l1_w_in = in[20]; p.conv_w = in[21]; p.conv_b = in[22]; p.c_norm = in[23]; p.d_qnorm = in[24]; p.d_knorm = in[25];
  p.pos_k = in[26]; p.w1_k = in[27]; p.w2_k = in[28]; p.pos_v = in[29]; p.w1_v = in[30]; p.w2_v = in[31];
  p.m1_wkv = in[32]; p.m1_qnorm = in[33]; p.m1_knorm = in[34]; p.l1_w_out = in[35];
  p.out = (float*)d_out;
  unsigned char* ws = (unsigned char*)d_ws;
  size_t off = 0;
  auto take = [&](size_t bytes) { unsigned char* r = ws + off; off += (bytes + 255) & ~(size_t)255; return r; };
  p.h = (u16*)take((size_t)T * 1024 * 2);
  p.proj = (u16*)take((size_t)T * LDP * 2);
  p.ycat = (u16*)take((size_t)T * MIX * 2);
  p.winT0 = (u16*)take((size_t)4096 * 1024 * 2);
  p.winT1 = (u16*)take((size_t)ODD_PAD * 1024 * 2);
  p.woutT0 = (u16*)take((size_t)1024 * MIX * 2);
  p.woutT1 = (u16*)take((size_t)1024 * MIX * 2);
  p.wkvT0 = (u16*)take((size_t)512 * 1024 * 2);
  p.wkvT1 = (u16*)take((size_t)512 * 1024 * 2);
  p.memn = (u16*)take((size_t)1024 * 1024 * 2);
  p.memkv0 = (u16*)take((size_t)1024 * 512 * 2);
  p.memkv1 = (u16*)take((size_t)1024 * 512 * 2);
  p.kc = (u16*)take((size_t)8 * 256 * 64 * 2);
  p.vc = nullptr;
  p.rope4 = (float*)take((size_t)SEQ * 8 * 4);
  p.rope8 = (float*)take((size_t)SEQ * 16 * 4);
  p.cbias = (float*)take(2 * 32 * 128 * 4);
  p.bar = (unsigned*)take((XCD_BAR_WORDS + 64) * 4);
  p.qctr = p.bar + XCD_BAR_WORDS;
  p.vcT = (u16*)take((size_t)8 * 64 * 256 * 2);
  p.wsb = (u16*)take((size_t)4 * 128 * 128 * 2);
  p.w1T_k = (u16*)take((size_t)128 * 2048 * 2);
  p.w1T_v = (u16*)take((size_t)128 * 2048 * 2);
  p.memvT0 = (u16*)take((size_t)16 * 64 * 256 * 2);
  p.memvT1 = (u16*)take((size_t)16 * 64 * 256 * 2);
  u16* vtbuf = (u16*)take((size_t)32 * SEQ * 64 * 2);
  p.vT = vtbuf;
  p.vsT = vtbuf;
  p.vwT = vtbuf + (size_t)8 * SEQ * 64;
  p.kd = nullptr; p.ksd = nullptr; p.kwd = nullptr;
  if (off > ws_size) fprintf(stderr, "workspace too small: need %zu have %zu\n", off, ws_size);

  static int grid_blocks = 0;
  if (!grid_blocks) {
    int dev = 0, cus = 0, per_cu = 0;
    hipGetDevice(&dev);
    hipDeviceGetAttribute(&cus, hipDeviceAttributeMultiprocessorCount, dev);
    hipOccupancyMaxActiveBlocksPerMultiprocessor(&per_cu, mega, 256, 0);
    if (per_cu < 1) per_cu = 1;
    grid_blocks = cus * per_cu;
  }
#if ONE_LAUNCH
  hipMemsetAsync(p.bar, 0, (XCD_BAR_WORDS + 64) * 4, stream);
  int lo = 0, hi = NPHASE;
  void* args[] = {&p, &lo, &hi};
  hipError_t e = hipLaunchCooperativeKernel((void*)mega, dim3(grid_blocks), dim3(256), args, 0, stream);
  if (e != hipSuccess) fprintf(stderr, "cooperative launch failed: %s (grid %d)\n", hipGetErrorString(e), grid_blocks);
#else
  for (int ph = 0; ph < NPHASE; ++ph) hipLaunchKernelGGL(mega, dim3(grid_blocks), dim3(256), 0, stream, p, ph, ph + 1);
#endif
}
```

```cpp
#include <hip/hip_runtime.h>
#include <hip/hip_cooperative_groups.h>
#include <cstdio>
#include <cstdint>
namespace cg = cooperative_groups;

#define DI __device__ __forceinline__
typedef unsigned short u16;
typedef unsigned long long u64;
using bf16x8 = __attribute__((ext_vector_type(8))) short;
using f32x16 = __attribute__((ext_vector_type(16))) float;
using u32x4 = __attribute__((ext_vector_type(4))) unsigned;

constexpr int BATCH = 4, SEQ = 4096, DM = 1024, T = BATCH * SEQ;
constexpr int LDP = 4096;
constexpr int ODD_IN = 3864, ODD_PAD = 3968;
constexpr int MIX = 1280;
constexpr float EPS = 1e-6f;
constexpr int A_U = 0, A_V = 512, A_G = 1024, B_Q = 1536, B_K = 2048, B_V = 2560, B_G = 3072, M0_Q = 3584, M0_G = 3840;
constexpr int C_A = 0, C_B = 512, C_G = 1024, D_Q = 1536, D_KV = 2048, D_G = 2816, M1_Q = 3328, M1_G = 3584, D_BG = 3840;
constexpr int NCMP = 255;

struct Params {
  const float *x, *mem, *mem_norm;
  const float *l0_norm, *l0_w_in, *a_vnorm, *a_ws, *a_bs, *b_qnorm, *b_knorm, *lq1, *lk1, *lq2, *lk2, *b_subln;
  const float *m0_wkv, *m0_qnorm, *m0_knorm, *l0_w_out;
  const float *l1_norm, *l1_w_in, *conv_w, *conv_b, *c_norm, *d_qnorm, *d_knorm;
  const float *pos_k, *w1_k, *w2_k, *pos_v, *w1_v, *w2_v;
  const float *m1_wkv, *m1_qnorm, *m1_knorm, *l1_w_out;
  float* out;
  u16 *h, *proj, *ycat, *winT0, *winT1, *woutT0, *woutT1, *wkvT0, *wkvT1, *memn, *memkv0, *memkv1, *kc, *vc, *vT, *memvT0, *memvT1, *vsT, *vwT, *vcT, *kd, *ksd, *kwd, *wsb, *w1T_k, *w1T_v;
  float *rope4, *rope8, *cbias;
  unsigned* bar;
  unsigned* qctr;
};

DI float bf2f(u16 u) { return __uint_as_float(((unsigned)u) << 16); }
DI u16 f2bf(float f) { unsigned u = __float_as_uint(f); u += 0x7fffu + ((u >> 16) & 1u); return (u16)(u >> 16); }
DI float wsum(float v) { for (int o = 32; o > 0; o >>= 1) v += __shfl_xor(v, o); return v; }
DI float wmax(float v) { for (int o = 32; o > 0; o >>= 1) v = fmaxf(v, __shfl_xor(v, o)); return v; }
DI float sigmoidf_(float x) { return __builtin_amdgcn_rcpf(1.f + __expf(-x)); }
DI float siluf_(float x) { return x * sigmoidf_(x); }
DI float geluf_(float x) { float u = 0.7978845608028654f * (x + 0.044715f * x * x * x); return x * __builtin_amdgcn_rcpf(1.f + __expf(-2.f * u)); }
DI void wave_sync() { __builtin_amdgcn_fence(__ATOMIC_SEQ_CST, "wavefront"); __builtin_amdgcn_wave_barrier(); }
DI int queue_pull(unsigned* ctr, int* slot) {
  __syncthreads();
  if (threadIdx.x == 0) *slot = (int)(gridDim.x + atomicAdd(ctr, 1u));
  __syncthreads();
  return *slot;
}
DI void ld8(const u16* p, float* v) {
  uint4 r = *(const uint4*)p;
  v[0] = __uint_as_float(r.x << 16); v[1] = __uint_as_float(r.x & 0xffff0000u);
  v[2] = __uint_as_float(r.y << 16); v[3] = __uint_as_float(r.y & 0xffff0000u);
  v[4] = __uint_as_float(r.z << 16); v[5] = __uint_as_float(r.z & 0xffff0000u);
  v[6] = __uint_as_float(r.w << 16); v[7] = __uint_as_float(r.w & 0xffff0000u);
}
DI void st8(u16* p, const float* v) {
  uint4 r;
  r.x = (unsigned)f2bf(v[0]) | ((unsigned)f2bf(v[1]) << 16);
  r.y = (unsigned)f2bf(v[2]) | ((unsigned)f2bf(v[3]) << 16);
  r.z = (unsigned)f2bf(v[4]) | ((unsigned)f2bf(v[5]) << 16);
  r.w = (unsigned)f2bf(v[6]) | ((unsigned)f2bf(v[7]) << 16);
  *(uint4*)p = r;
}

constexpr int GBK = 64, GLD = 72;
constexpr int SMEM_BYTES = 2 * 128 * GLD * 2;

DI void gemm_mainloop(f32x16 (&acc)[2][2], const u16* __restrict__ A, int lda, const u16* __restrict__ Bt, int ldb, int K, int m0, int n0,
                      u16* smem) {
  u16* As = smem;
  u16* Bs = smem + 128 * GLD;
  const int tid = threadIdx.x, lane = tid & 63, w = tid >> 6;
  const int wm = w >> 1, wn = w & 1;
  const int l31 = lane & 31, hh = lane >> 5;
#pragma unroll
  for (int i = 0; i < 2; ++i)
#pragma unroll
    for (int j = 0; j < 2; ++j)
#pragma unroll
      for (int r = 0; r < 16; ++r) acc[i][j][r] = 0.f;
  u32x4 ra[4], rb[4];
  const int nk = K / GBK;
#pragma unroll
  for (int i = 0; i < 4; ++i) {
    int c = tid + 256 * i, row = c >> 3, c8 = c & 7;
    ra[i] = *(const u32x4*)(A + (size_t)(m0 + row) * lda + c8 * 8);
    rb[i] = *(const u32x4*)(Bt + (size_t)(n0 + row) * ldb + c8 * 8);
  }
  for (int kt = 0; kt < nk; ++kt) {
    __syncthreads();
#pragma unroll
    for (int i = 0; i < 4; ++i) {
      int c = tid + 256 * i, row = c >> 3, c8 = c & 7;
      *(u32x4*)(As + row * GLD + c8 * 8) = ra[i];
      *(u32x4*)(Bs + row * GLD + c8 * 8) = rb[i];
    }
    __syncthreads();
    if (kt + 1 < nk) {
      const int k0 = (kt + 1) * GBK;
#pragma unroll
      for (int i = 0; i < 4; ++i) {
        int c = tid + 256 * i, row = c >> 3, c8 = c & 7;
        ra[i] = *(const u32x4*)(A + (size_t)(m0 + row) * lda + k0 + c8 * 8);
        rb[i] = *(const u32x4*)(Bt + (size_t)(n0 + row) * ldb + k0 + c8 * 8);
      }
    }
#pragma unroll
    for (int kk = 0; kk < 4; ++kk) {
      bf16x8 af[2], bfr[2];
#pragma unroll
      for (int i = 0; i < 2; ++i) {
        af[i] = *(const bf16x8*)(As + (wm * 64 + i * 32 + l31) * GLD + kk * 16 + hh * 8);
        bfr[i] = *(const bf16x8*)(Bs + (wn * 64 + i * 32 + l31) * GLD + kk * 16 + hh * 8);
      }
#pragma unroll
      for (int i = 0; i < 2; ++i)
#pragma unroll
        for (int j = 0; j < 2; ++j) acc[i][j] = __builtin_amdgcn_mfma_f32_32x32x16_bf16(af[i], bfr[j], acc[i][j], 0, 0, 0);
    }
  }
}

template <class Epi>
DI void gemm_tile(const u16* __restrict__ A, int lda, const u16* __restrict__ Bt, int ldb, int K, int m0, int n0,
                  u16* smem, Epi epi) {
  const int tid = threadIdx.x, lane = tid & 63, w = tid >> 6;
  const int wm = w >> 1, wn = w & 1;
  const int l31 = lane & 31, hh = lane >> 5;
  f32x16 acc[2][2];
  gemm_mainloop(acc, A, lda, Bt, ldb, K, m0, n0, smem);
#pragma unroll
  for (int i = 0; i < 2; ++i)
#pragma unroll
    for (int j = 0; j < 2; ++j)
#pragma unroll
      for (int r = 0; r < 16; ++r) {
        int row = m0 + wm * 64 + i * 32 + (r & 3) + 8 * (r >> 2) + 4 * hh;
        int col = n0 + wn * 64 + j * 32 + l31;
        epi(row, col, acc[i][j][r]);
      }
}

struct EpiBf16 {
  u16* C; int ldc; int N;
  DI void operator()(int row, int col, float v) const { if (col < N) C[(size_t)row * ldc + col] = f2bf(v); }
};
struct EpiResid {
  const float* X; float* O; int ld;
  DI void operator()(int row, int col, float v) const { size_t i = (size_t)row * ld + col; O[i] = X[i] + v; }
};
DI void gemm_tile_resid(const u16* __restrict__ A, int lda, const u16* __restrict__ Bt, int ldb, int K, int m0, int n0,
                        u16* smem, const float* X, float* O, int ld) {
  const int tid = threadIdx.x, lane = tid & 63, w = tid >> 6;
  const int wm = w >> 1, wn = w & 1;
  const int l31 = lane & 31, hh = lane >> 5;
  f32x16 acc[2][2];
  gemm_mainloop(acc, A, lda, Bt, ldb, K, m0, n0, smem);
#pragma unroll
  for (int i = 0; i < 2; ++i)
#pragma unroll
    for (int j = 0; j < 2; ++j) {
      const size_t base = (size_t)(m0 + wm * 64 + i * 32 + 4 * hh) * ld + n0 + wn * 64 + j * 32 + l31;
      float xv[16];
#pragma unroll
      for (int r = 0; r < 16; ++r) xv[r] = X[base + (size_t)((r & 3) + 8 * (r >> 2)) * ld];
#pragma unroll
      for (int r = 0; r < 16; ++r) O[base + (size_t)((r & 3) + 8 * (r >> 2)) * ld] = xv[r] + acc[i][j][r];
    }
}

DI void transpose_cvt_tile(const float* __restrict__ W, int K, int N, u16* __restrict__ WT, int item, float* tile, bool perm = false) {
  const int nkt = K / 64;
  const int kt = item % nkt, nt = item / nkt;
  const int k0 = kt * 64, n0 = nt * 64;
  __syncthreads();
  for (int i = threadIdx.x; i < 4096; i += 256) {
    int r = i >> 6, c = i & 63;
    int sc = n0 + c;
    if (perm) sc = sc < 2816 ? sc : sc < 3840 ? sc + 24 : sc < 3864 ? sc - 1024 : N;
    const float wvv = W[(size_t)(k0 + r) * N + (sc < N ? sc : N - 1)];
    float v = (sc < N) ? wvv : 0.f;
    tile[r * 65 + c] = v;
  }
  __syncthreads();
  for (int i = threadIdx.x; i < 4096; i += 256) {
    int r = i >> 6, c = i & 63;
    WT[(size_t)(n0 + r) * K + k0 + c] = f2bf(tile[c * 65 + r]);
  }
}

DI void rmsnorm_row(const float* __restrict__ src, const float* __restrict__ g, u16* __restrict__ dst, int lane) {
  float4 v[4];
  float ss = 0.f;
#pragma unroll
  for (int i = 0; i < 4; ++i) {
    v[i] = *(const float4*)(src + (i * 64 + lane) * 4);
    ss += v[i].x * v[i].x + v[i].y * v[i].y + v[i].z * v[i].z + v[i].w * v[i].w;
  }
  ss = wsum(ss);
  float rs = rsqrtf(ss * (1.f / 1024.f) + EPS);
#pragma unroll
  for (int i = 0; i < 4; ++i) {
    float4 gg = *(const float4*)(g + (i * 64 + lane) * 4);
    uint2 o;
    o.x = (unsigned)f2bf(v[i].x * rs * gg.x) | ((unsigned)f2bf(v[i].y * rs * gg.y) << 16);
    o.y = (unsigned)f2bf(v[i].z * rs * gg.z) | ((unsigned)f2bf(v[i].w * rs * gg.w) << 16);
    *(uint2*)(dst + (i * 64 + lane) * 4) = o;
  }
}

DI void phase0(const Params& p, float* smf) {
  const int n_win0 = 16 * 64, n_win1 = 16 * 62, n_wout = 20 * 16, n_wkv = 16 * 8;
  const int c1 = n_win0, c2 = c1 + n_win1, c3 = c2 + n_wout, c4 = c3 + n_wout, c5 = c4 + n_wkv, c6 = c5 + n_wkv;
  const int c7 = c6 + (1024 + T) / 4;
  const int c8 = c7 + 16;
  const int c9 = c8 + 64;
  const int c10 = c9 + 2 * 32 * 2;
  const int c11 = c10 + 64;
  const int lane = threadIdx.x & 63, w = threadIdx.x >> 6;
  for (int it = blockIdx.x; it < c11; it += gridDim.x) {
    if (it < c1) transpose_cvt_tile(p.l0_w_in, 1024, 4096, p.winT0, it, smf);
    else if (it < c2) transpose_cvt_tile(p.l1_w_in, 1024, ODD_IN, p.winT1, it - c1, smf, true);
    else if (it < c3) transpose_cvt_tile(p.l0_w_out, MIX, 1024, p.woutT0, it - c2, smf);
    else if (it < c4) transpose_cvt_tile(p.l1_w_out, MIX, 1024, p.woutT1, it - c3, smf);
    else if (it < c5) transpose_cvt_tile(p.m0_wkv, 1024, 512, p.wkvT0, it - c4, smf);
    else if (it < c6) transpose_cvt_tile(p.m1_wkv, 1024, 512, p.wkvT1, it - c5, smf);
    else if (it < c7) {
      int row = (it - c6) * 4 + w;
      if (row < 1024) rmsnorm_row(p.mem + (size_t)row * 1024, p.mem_norm, p.memn + (size_t)row * 1024, lane);
      else { row -= 1024; rmsnorm_row(p.x + (size_t)row * 1024, p.l0_norm, p.h + (size_t)row * 1024, lane); }
    } else if (it < c8) {
      int pos = (it - c7) * 256 + threadIdx.x;
      for (int i = 0; i < 4; ++i) {
        float inv = powf(500000.f, -(float)i / 4.f);
        float ang = (float)pos * inv;
        p.rope4[pos * 8 + i] = cosf(ang); p.rope4[pos * 8 + 4 + i] = sinf(ang);
      }
      for (int i = 0; i < 8; ++i) {
        float inv = powf(500000.f, -(float)i / 8.f);
        float ang = (float)pos * inv;
        p.rope8[pos * 16 + i] = cosf(ang); p.rope8[pos * 16 + 8 + i] = sinf(ang);
      }
    } else if (it >= c10) {
      const int e0 = (it - c10) * 1024;
      for (int e = e0 + threadIdx.x; e < e0 + 1024; e += 256) {
        const int t = (e >> 7) & 127, sidx = e & 127;
        p.wsb[e] = sidx <= t ? f2bf(p.a_ws[e]) : (u16)0;
      }
    } else if (it >= c9) {
      const int e = it - c9;
      if (e < 64) transpose_cvt_tile(p.w1_k, 2048, 128, p.w1T_k, e, smf);
      else transpose_cvt_tile(p.w1_v, 2048, 128, p.w1T_v, e - 64, smf);
    } else {
      const int which = (it - c8) >> 5, l = (it - c8) & 31;
      const float* pe = (which ? p.pos_v : p.pos_k) + l * 64;
      const float* w1 = (which ? p.w1_v : p.w1_k) + (size_t)l * 64 * 128;
      if (threadIdx.x < 128) {
        float a = 0.f;
#pragma unroll 8
        for (int k = 0; k < 64; ++k) a += pe[k] * w1[k * 128 + threadIdx.x];
        p.cbias[(which * 32 + l) * 128 + threadIdx.x] = a;
      }
    }
  }
}

DI void phase_gemm_in(const Params& p, int layer, u16* smem) {
  const u16* Bt = layer ? p.winT1 : p.winT0;
  const int N = layer ? ODD_IN : 4096;
  const int ntn = layer ? 31 : 32;
  const int main_items = (T / 128) * ntn;
  const int extra = layer ? 0 : 2 * 8 * 4;
  for (int it = blockIdx.x; it < main_items + extra; it += gridDim.x) {
    if (it < main_items) {
      int mt = it / ntn, nt = it % ntn;
      gemm_tile(p.h, 1024, Bt, 1024, 1024, mt * 128, nt * 128, smem, EpiBf16{p.proj, LDP, N});
    } else {
      int e = it - main_items;
      int l = e / 32, r = e % 32, mt = r / 4, nt = r % 4;
      gemm_tile(p.memn, 1024, l ? p.wkvT1 : p.wkvT0, 1024, 1024, mt * 128, nt * 128, smem,
                EpiBf16{l ? p.memkv1 : p.memkv0, 512, 512});
    }
  }
}
DI void phase_gemm_out(const Params& p, int layer, u16* smem) {
  const u16* Bt = layer ? p.woutT1 : p.woutT0;
  const float* X = layer ? p.out : p.x;
  const int items = (T / 128) * 8;
  for (int it = blockIdx.x; it < items; it += gridDim.x) {
    int mt = it / 8, nt = it % 8;
    gemm_tile_resid(p.ycat, MIX, Bt, MIX, MIX, mt * 128, nt * 128, smem, X, p.out, 1024);
  }
}

typedef __bf16 bf2_t __attribute__((ext_vector_type(2)));
typedef float f2_t __attribute__((ext_vector_type(2)));
DI unsigned pk_bf16(float a, float b) { f2_t v = {a, b}; bf2_t r = __builtin_convertvector(v, bf2_t); return __builtin_bit_cast(unsigned, r); }
#define MFMA32(a, b, c) __builtin_amdgcn_mfma_f32_32x32x16_bf16((a), (b), (c), 0, 0, 0)
constexpr int KLD = 72;
constexpr int KV_BUF = 2 * 64 * KLD;

struct FAState { f32x16 o[2]; float m, l; };
DI void fa_init(FAState& s) {
#pragma unroll
  for (int i = 0; i < 16; ++i) { s.o[0][i] = 0.f; s.o[1][i] = 0.f; }
  s.m = -INFINITY; s.l = 0.f;
}
DI bf16x8 frag_first(float v, int hh) {
  bf16x8 a = {0, 0, 0, 0, 0, 0, 0, 0};
  if (hh == 0) a[0] = (short)f2bf(v);
  return a;
}
DI bf16x8 scale_frag(const bf16x8& q, float c) {
  u32x4 u;
#pragma unroll
  for (int j = 0; j < 4; ++j) u[j] = pk_bf16(bf2f((u16)q[2 * j]) * c, bf2f((u16)q[2 * j + 1]) * c);
  return __builtin_bit_cast(bf16x8, u);
}
template <int DK>
DI void fa_scores(f32x16 (&s)[2], const bf16x8* qf, const u16* Ks, int l31, int hh, const bf16x8& aone, const bf16x8& qx) {
#pragma unroll
  for (int sub = 0; sub < 2; ++sub) {
#pragma unroll
    for (int i = 0; i < 16; ++i) s[sub][i] = 0.f;
    bf16x8 a[DK / 16];
#pragma unroll
    for (int ks = 0; ks < DK / 16; ++ks) a[ks] = *(const bf16x8*)(Ks + (sub * 32 + l31) * KLD + ks * 16 + hh * 8);
    __builtin_amdgcn_s_setprio(1);
#pragma unroll
    for (int ks = 0; ks < DK / 16; ++ks) s[sub] = MFMA32(a[ks], qf[ks], s[sub]);
    s[sub] = MFMA32(aone, qx, s[sub]);
    __builtin_amdgcn_s_setprio(0);
  }
}
DI void fa_mask(f32x16 (&s)[2], int k0, int lo, int hi, int hh) {
#pragma unroll
  for (int sub = 0; sub < 2; ++sub)
#pragma unroll
    for (int i = 0; i < 16; ++i) {
      const int key = k0 + sub * 32 + (i & 3) + 8 * (i >> 2) + 4 * hh;
      if (key < lo || key > hi) s[sub][i] = -INFINITY;
    }
}
DI bf16x8 pack8(const f32x16& x, int base) {
  u32x4 u;
  u[0] = pk_bf16(x[base + 0], x[base + 1]); u[1] = pk_bf16(x[base + 2], x[base + 3]);
  u[2] = pk_bf16(x[base + 4], x[base + 5]); u[3] = pk_bf16(x[base + 6], x[base + 7]);
  return __builtin_bit_cast(bf16x8, u);
}
DI void fa_pv(FAState& st, const bf16x8* pf, const u16* Vt, int l31, int hh) {
#pragma unroll
  for (int dsub = 0; dsub < 2; ++dsub) {
    bf16x8 vf[4];
#pragma unroll
    for (int ks = 0; ks < 4; ++ks) {
      vf[ks] = *(const bf16x8*)(Vt + (dsub * 32 + l31) * KLD + ks * 16 + 8 * hh);
    }
    __builtin_amdgcn_s_setprio(1);
#pragma unroll
    for (int ks = 0; ks < 4; ++ks) st.o[dsub] = MFMA32(vf[ks], pf[ks], st.o[dsub]);
    __builtin_amdgcn_s_setprio(0);
  }
}
DI void fa_softmax_pv(FAState& st, f32x16 (&s)[2], const u16* Vt, int l31, int hh) {
  float rs = 0.f;
#pragma unroll
  for (int sub = 0; sub < 2; ++sub)
#pragma unroll
    for (int i = 0; i < 16; ++i) { float pe = __builtin_amdgcn_exp2f(s[sub][i]); s[sub][i] = pe; rs += pe; }
  st.l += rs;
  bf16x8 pf[4];
#pragma unroll
  for (int ks = 0; ks < 4; ++ks) pf[ks] = pack8(s[ks >> 1], (ks & 1) * 8);
  fa_pv(st, pf, Vt, l31, hh);
}
DI float fa_rowsum(const FAState& st) { return st.l + __shfl_xor(st.l, 32); }
DI void fa_softmax_pack(FAState& st, f32x16 (&s)[2], bf16x8 (&pf)[4]) {
  float rs = 0.f;
#pragma unroll
  for (int sub = 0; sub < 2; ++sub)
#pragma unroll
    for (int i = 0; i < 16; ++i) { float pe = __builtin_amdgcn_exp2f(s[sub][i]); s[sub][i] = pe; rs += pe; }
  st.l += rs;
#pragma unroll
  for (int ks = 0; ks < 4; ++ks) pf[ks] = pack8(s[ks >> 1], (ks & 1) * 8);
}
DI void fa_pv2(FAState& st0, FAState& st1, const bf16x8* pf0, const bf16x8* pf1, const u16* Vt, int l31, int hh) {
#pragma unroll
  for (int dsub = 0; dsub < 2; ++dsub) {
    bf16x8 vf[4];
#pragma unroll
    for (int ks = 0; ks < 4; ++ks) {
      vf[ks] = *(const bf16x8*)(Vt + (dsub * 32 + l31) * KLD + ks * 16 + 8 * hh);
    }
    __builtin_amdgcn_s_setprio(1);
#pragma unroll
    for (int ks = 0; ks < 4; ++ks) { st0.o[dsub] = MFMA32(vf[ks], pf0[ks], st0.o[dsub]); st1.o[dsub] = MFMA32(vf[ks], pf1[ks], st1.o[dsub]); }
    __builtin_amdgcn_s_setprio(0);
  }
}
template <int NKS>
DI float q_norm2(const bf16x8* qf) {
  float ss = 0.f;
#pragma unroll
  for (int ks = 0; ks < NKS; ++ks)
#pragma unroll
    for (int j = 0; j < 8; ++j) { float v = bf2f((u16)qf[ks][j]); ss += v * v; }
  return ss + __shfl_xor(ss, 32);
}
DI float gain_absmax(const float* g, int n, int lane) { return wmax(lane < n ? fabsf(g[lane]) : 0.f); }

template <class Src, class Comp>
DI void kv_pipeline(int nsteps, u16* smem, Src src, Comp comp) {
  const int tid = threadIdx.x, r0 = tid >> 3, c8 = (tid & 7) * 8;
  u32x4 kr0, kr1, vr0, vr1;
  const u16 *kp, *vp; int ks, vs;
  if (nsteps <= 0) return;
  src(0, kp, ks, vp, vs);
  kr0 = *(const u32x4*)(kp + (size_t)r0 * ks + c8); kr1 = *(const u32x4*)(kp + (size_t)(r0 + 32) * ks + c8);
  vr0 = *(const u32x4*)(vp + (size_t)r0 * vs + c8); vr1 = *(const u32x4*)(vp + (size_t)(r0 + 32) * vs + c8);
  __syncthreads();
  *(u32x4*)(smem + r0 * KLD + c8) = kr0; *(u32x4*)(smem + (r0 + 32) * KLD + c8) = kr1;
  *(u32x4*)(smem + 64 * KLD + r0 * KLD + c8) = vr0; *(u32x4*)(smem + 64 * KLD + (r0 + 32) * KLD + c8) = vr1;
  __syncthreads();
  for (int t = 0; t < nsteps; ++t) {
    if (t + 1 < nsteps) {
      src(t + 1, kp, ks, vp, vs);
      kr0 = *(const u32x4*)(kp + (size_t)r0 * ks + c8); kr1 = *(const u32x4*)(kp + (size_t)(r0 + 32) * ks + c8);
      vr0 = *(const u32x4*)(vp + (size_t)r0 * vs + c8); vr1 = *(const u32x4*)(vp + (size_t)(r0 + 32) * vs + c8);
    }
    u16* Ks = smem + (t & 1) * KV_BUF;
    comp(t, (const u16*)Ks, (const u16*)(Ks + 64 * KLD));
    if (t + 1 < nsteps) {
      u16* nb = smem + ((t + 1) & 1) * KV_BUF;
      *(u32x4*)(nb + r0 * KLD + c8) = kr0; *(u32x4*)(nb + (r0 + 32) * KLD + c8) = kr1;
      *(u32x4*)(nb + 64 * KLD + r0 * KLD + c8) = vr0; *(u32x4*)(nb + 64 * KLD + (r0 + 32) * KLD + c8) = vr1;
    }
    __syncthreads();
  }
}

DI void transpose64(const u16* __restrict__ src, int lds, u16* __restrict__ dst, int ldd, u16* sm) {
  const int tid = threadIdx.x;
  __syncthreads();
  for (int c = tid; c < 512; c += 256) {
    int r = c >> 3, c8 = (c & 7) * 8;
    *(u32x4*)(sm + r * KLD + c8) = *(const u32x4*)(src + (size_t)r * lds + c8);
  }
  __syncthreads();
  const int d = tid >> 2, tc = tid & 3;
  unsigned u[8];
#pragma unroll
  for (int i = 0; i < 8; ++i)
    u[i] = (unsigned)sm[(tc * 16 + 2 * i) * KLD + d] | ((unsigned)sm[(tc * 16 + 2 * i + 1) * KLD + d] << 16);
  u32x4 a = {u[0], u[1], u[2], u[3]}, b = {u[4], u[5], u[6], u[7]};
  *(u32x4*)(dst + (size_t)d * ldd + tc * 16) = a;
  *(u32x4*)(dst + (size_t)d * ldd + tc * 16 + 8) = b;
}

DI void diffattn_item(const Params& p, int b, int h, int qt, float lam, u16* smem) {
  const int lane = threadIdx.x & 63, w = threadIdx.x >> 6, l31 = lane & 31, hh = lane >> 5;
  const int q0w = qt * 128 + w * 32, myq = q0w + l31;
  const size_t tok = (size_t)b * SEQ + myq;
  bf16x8 qf[2][2];
  {
    const u16* qrow = p.proj + tok * LDP + B_Q + h * 64;
#pragma unroll
    for (int m = 0; m < 2; ++m)
#pragma unroll
      for (int ks = 0; ks < 2; ++ks) qf[m][ks] = *(const bf16x8*)(qrow + m * 32 + ks * 16 + hh * 8);
  }
  FAState st[2];
  fa_init(st[0]); fa_init(st[1]);
  const u16* kbase = p.proj + (size_t)(b * SEQ) * LDP + B_K + h * 64;
  const u16* vtbase = p.vT + (size_t)(b * 8 + h) * SEQ * 64;
  const float c = 0.17677669529663687f * 1.4426950408889634f;
  const float kmax = 5.656854249f * 1.01f * gain_absmax(p.b_knorm, 32, lane);
  const bf16x8 aone = frag_first(1.f, hh);
  bf16x8 qx[2];
#pragma unroll
  for (int m = 0; m < 2; ++m) {
    qf[m][0] = scale_frag(qf[m][0], c); qf[m][1] = scale_frag(qf[m][1], c);
    qx[m] = frag_first(-kmax * sqrtf(q_norm2<2>(qf[m])), hh);
  }
  kv_pipeline(2 * qt + 2, smem,
    [&](int j, const u16*& kp, int& ks, const u16*& vp, int& vs) { kp = kbase + (size_t)(j * 64) * LDP; ks = LDP; vp = vtbase + (size_t)j * 4096; vs = 64; },
    [&](int j, const u16* Ks, const u16* Vt) {
      const int k0 = j * 64;
      if (k0 <= q0w + 31) {
        const bool need_mask = (k0 + 63 > q0w);
        bf16x8 pf[2][4];
#pragma unroll
        for (int m = 0; m < 2; ++m) {
          f32x16 s[2];
          fa_scores<32>(s, qf[m], Ks + m * 32, l31, hh, aone, qx[m]);
          if (need_mask) fa_mask(s, k0, 0, myq, hh);
          fa_softmax_pack(st[m], s, pf[m]);
          __builtin_amdgcn_sched_barrier(0);
        }
        fa_pv2(st[0], st[1], pf[0], pf[1], Vt, l31, hh);
        __builtin_amdgcn_sched_barrier(0);
      }
    });
  const float i0 = 1.f / fa_rowsum(st[0]), i1 = lam / fa_rowsum(st[1]);
  float ss = 0.f;
#pragma unroll
  for (int d = 0; d < 2; ++d)
#pragma unroll
    for (int i = 0; i < 16; ++i) { float o = st[0].o[d][i] * i0 - st[1].o[d][i] * i1; st[0].o[d][i] = o; ss += o * o; }
  ss += __shfl_xor(ss, 32);
  const float lam_init = 0.8f - 0.6f * 0.7408182206817179f;
  const float rs = rsqrtf(ss * (1.f / 64.f) + EPS) * (1.f - lam_init);
  uint2 gqs[2][4];
#pragma unroll
  for (int d = 0; d < 2; ++d)
#pragma unroll
    for (int a = 0; a < 4; ++a) gqs[d][a] = *(const uint2*)(p.proj + tok * LDP + B_G + h * 64 + d * 32 + 8 * a + 4 * hh);
#pragma unroll
  for (int d = 0; d < 2; ++d)
#pragma unroll
    for (int a = 0; a < 4; ++a) {
      const int dim = d * 32 + 8 * a + 4 * hh;
      uint2 gq = gqs[d][a];
      float g0 = __uint_as_float(gq.x << 16), g1 = __uint_as_float(gq.x & 0xffff0000u);
      float g2 = __uint_as_float(gq.y << 16), g3 = __uint_as_float(gq.y & 0xffff0000u);
      float y0 = st[0].o[d][4 * a + 0] * rs * p.b_subln[dim + 0] * siluf_(g0);
      float y1 = st[0].o[d][4 * a + 1] * rs * p.b_subln[dim + 1] * siluf_(g1);
      float y2 = st[0].o[d][4 * a + 2] * rs * p.b_subln[dim + 2] * siluf_(g2);
      float y3 = st[0].o[d][4 * a + 3] * rs * p.b_subln[dim + 3] * siluf_(g3);
      uint2 o; o.x = pk_bf16(y0, y1); o.y = pk_bf16(y2, y3);
      *(uint2*)(p.ycat + tok * MIX + 512 + h * 64 + dim) = o;
    }
}

DI void memattn_item(const Params& p, int layer, int b, int h, int qt, u16* smem) {
  const int lane = threadIdx.x & 63, w = threadIdx.x >> 6, l31 = lane & 31, hh = lane >> 5;
  const int myq = qt * 128 + w * 32 + l31;
  const size_t tok = (size_t)b * SEQ + myq;
  const int qcol = layer ? M1_Q : M0_Q, gcol = layer ? M1_G : M0_G;
  bf16x8 qf[4];
#pragma unroll
  for (int ks = 0; ks < 4; ++ks) qf[ks] = *(const bf16x8*)(p.proj + tok * LDP + qcol + h * 64 + ks * 16 + hh * 8);
  FAState st; fa_init(st);
  const u16* kbase = (layer ? p.memkv1 : p.memkv0) + (size_t)(b * 256) * 512 + h * 64;
  const u16* vtbase = (layer ? p.memvT1 : p.memvT0) + (size_t)((b * 4 + h) * 64) * 256;
  const float c = 0.125f * 1.4426950408889634f;
#pragma unroll
  for (int ks = 0; ks < 4; ++ks) qf[ks] = scale_frag(qf[ks], c);
  const bf16x8 aone = frag_first(1.f, hh);
  const bf16x8 qx = frag_first(-8.f * 1.01f * gain_absmax(layer ? p.m1_knorm : p.m0_knorm, 64, lane) * sqrtf(q_norm2<4>(qf)), hh);
  kv_pipeline(4, smem,
    [&](int j, const u16*& kp, int& ks, const u16*& vp, int& vs) { kp = kbase + (size_t)(j * 64) * 512; ks = 512; vp = vtbase + j * 64; vs = 256; },
    [&](int j, const u16* Ks, const u16* Vt) {
      f32x16 s[2];
      fa_scores<64>(s, qf, Ks, l31, hh, aone, qx);
      fa_softmax_pv(st, s, Vt, l31, hh);
    });
  const float il = 1.f / fa_rowsum(st);
  uint2 gqs[2][4];
#pragma unroll
  for (int d = 0; d < 2; ++d)
#pragma unroll
    for (int a = 0; a < 4; ++a) gqs[d][a] = *(const uint2*)(p.proj + tok * LDP + gcol + h * 64 + d * 32 + 8 * a + 4 * hh);
#pragma unroll
  for (int d = 0; d < 2; ++d)
#pragma unroll
    for (int a = 0; a < 4; ++a) {
      const int dim = d * 32 + 8 * a + 4 * hh;
      uint2 gq = gqs[d][a];
      float g0 = __uint_as_float(gq.x << 16), g1 = __uint_as_float(gq.x & 0xffff0000u);
      float g2 = __uint_as_float(gq.y << 16), g3 = __uint_as_float(gq.y & 0xffff0000u);
      uint2 o;
      o.x = pk_bf16(st.o[d][4 * a + 0] * il * siluf_(g0), st.o[d][4 * a + 1] * il * siluf_(g1));
      o.y = pk_bf16(st.o[d][4 * a + 2] * il * siluf_(g2), st.o[d][4 * a + 3] * il * siluf_(g3));
      *(uint2*)(p.ycat + tok * MIX + 1024 + h * 64 + dim) = o;
    }
}

constexpr int SLD = 136;
DI void sgu_item_mfma(const Params& p, int item, u16* smem) {
  const int g = item & 3; item >>= 2;
  const int cidx = item & 31; item >>= 5;
  const int b = item;
  const int tok0 = b * SEQ + cidx * 128;
  const int tid = threadIdx.x, lane = tid & 63, w = tid >> 6, l31 = lane & 31, hh = lane >> 5;
  __syncthreads();
  for (int i = tid; i < 2048; i += 256) {
    const int s = i & 127, c8 = (i >> 7) * 8;
    u32x4 v = *(const u32x4*)(p.proj + (size_t)(tok0 + s) * LDP + A_V + g * 128 + c8);
#pragma unroll
    for (int e = 0; e < 4; ++e) {
      smem[(c8 + 2 * e) * SLD + s] = (u16)(v[e] & 0xffffu);
      smem[(c8 + 2 * e + 1) * SLD + s] = (u16)(v[e] >> 16);
    }
  }
  __syncthreads();
  f32x16 acc[4];
#pragma unroll
  for (int ti = 0; ti < 4; ++ti)
#pragma unroll
    for (int i = 0; i < 16; ++i) acc[ti][i] = 0.f;
  const u16* Wb = p.wsb + (size_t)g * 128 * 128;
#pragma unroll
  for (int ks = 0; ks < 8; ++ks) {
    const bf16x8 bfr = *(const bf16x8*)(smem + (w * 32 + l31) * SLD + ks * 16 + hh * 8);
#pragma unroll
    for (int ti = 0; ti < 4; ++ti) {
      if (ks * 16 <= ti * 32 + 31) {
        const bf16x8 af = *(const bf16x8*)(Wb + (ti * 32 + l31) * 128 + ks * 16 + hh * 8);
        acc[ti] = MFMA32(af, bfr, acc[ti]);
      }
    }
  }
  const int d = w * 32 + l31;
#pragma unroll
  for (int ti = 0; ti < 4; ++ti) {
    u16 uv[16], gv[16];
    float bs[16];
#pragma unroll
    for (int i = 0; i < 16; ++i) {
      const int t = ti * 32 + (i & 3) + 8 * (i >> 2) + 4 * hh;
      const u16* row = p.proj + (size_t)(tok0 + t) * LDP;
      uv[i] = row[A_U + g * 128 + d]; gv[i] = row[A_G + g * 128 + d]; bs[i] = p.a_bs[g * 128 + t];
    }
#pragma unroll
    for (int i = 0; i < 16; ++i) {
      const int t = ti * 32 + (i & 3) + 8 * (i >> 2) + 4 * hh;
      const float z = acc[ti][i] + bs[i];
      p.ycat[(size_t)(tok0 + t) * MIX + g * 128 + d] = f2bf(geluf_(bf2f(uv[i])) * z * siluf_(bf2f(gv[i])));
    }
  }
}

DI void compress_item_mfma(const Params& p, int item, float* smf) {
  const int nch = item & 7; item >>= 3;
  const int g = item & 1; item >>= 1;
  const int b = item & 3; item >>= 2;
  const int which = item;
  const int tid = threadIdx.x, lane = tid & 63, w = tid >> 6, l31 = lane & 31, hh = lane >> 5;
  const int n0 = nch * 32;
  const int nrow = min(n0 + l31, NCMP - 1);
  u16* As = (u16*)smf;
  u16* Bs = (u16*)smf + 32 * KLD;
  const int arow = tid >> 3, ac8 = (tid & 7) * 8;
  const u16* asrc = p.proj + (size_t)(b * SEQ + 16 * min(n0 + arow, NCMP - 1)) * LDP + D_KV + which * 128 + g * 64 + ac8;
  const u16* bsrc = (which ? p.w1T_v : p.w1T_k) + (size_t)arow * 2048 + ac8;
  (void)nrow;
  f32x16 acc;
#pragma unroll
  for (int i = 0; i < 16; ++i) acc[i] = 0.f;
  u32x4 ra, rb0, rb1, rb2, rb3;
  ra = *(const u32x4*)(asrc);
  rb0 = *(const u32x4*)(bsrc); rb1 = *(const u32x4*)(bsrc + (size_t)32 * 2048);
  rb2 = *(const u32x4*)(bsrc + (size_t)64 * 2048); rb3 = *(const u32x4*)(bsrc + (size_t)96 * 2048);
#pragma unroll 2
  for (int l = 0; l < 32; ++l) {
    __syncthreads();
    *(u32x4*)(As + arow * KLD + ac8) = ra;
    *(u32x4*)(Bs + arow * KLD + ac8) = rb0; *(u32x4*)(Bs + (arow + 32) * KLD + ac8) = rb1;
    *(u32x4*)(Bs + (arow + 64) * KLD + ac8) = rb2; *(u32x4*)(Bs + (arow + 96) * KLD + ac8) = rb3;
    __syncthreads();
    {
      const int ln = l + 1 < 32 ? l + 1 : 31;
      ra = *(const u32x4*)(asrc + (size_t)ln * LDP);
      const u16* bp = bsrc + ln * 64;
      rb0 = *(const u32x4*)(bp); rb1 = *(const u32x4*)(bp + (size_t)32 * 2048);
      rb2 = *(const u32x4*)(bp + (size_t)64 * 2048); rb3 = *(const u32x4*)(bp + (size_t)96 * 2048);
    }
#pragma unroll
    for (int kk = 0; kk < 4; ++kk) {
      const bf16x8 af = *(const bf16x8*)(As + l31 * KLD + kk * 16 + hh * 8);
      const bf16x8 bfr = *(const bf16x8*)(Bs + (w * 32 + l31) * KLD + kk * 16 + hh * 8);
      acc = MFMA32(af, bfr, acc);
    }
  }
  float* hid = smf;
  float* biasL = smf + 32 * 132;
  const float* w2 = which ? p.w2_v : p.w2_k;
  __syncthreads();
  if (tid < 128) {
    float s = 0.f;
#pragma unroll 4
    for (int l = 0; l < 32; ++l) s += p.cbias[(which * 32 + l) * 128 + tid];
    biasL[tid] = s;
  }
  __syncthreads();
#pragma unroll
  for (int i = 0; i < 16; ++i) {
    const int r = (i & 3) + 8 * (i >> 2) + 4 * hh, j = w * 32 + l31;
    hid[r * 132 + j] = siluf_(acc[i] + biasL[j]);
  }
  __syncthreads();
  const int r = tid >> 3, e0 = (tid & 7) * 8;
  float o[8];
#pragma unroll
  for (int e = 0; e < 8; ++e) o[e] = 0.f;
#pragma unroll 4
  for (int j = 0; j < 128; ++j) {
    const float hv = hid[r * 132 + j];
    const float4 wa = *(const float4*)(w2 + j * 64 + e0), wb = *(const float4*)(w2 + j * 64 + e0 + 4);
    o[0] += hv * wa.x; o[1] += hv * wa.y; o[2] += hv * wa.z; o[3] += hv * wa.w;
    o[4] += hv * wb.x; o[5] += hv * wb.y; o[6] += hv * wb.z; o[7] += hv * wb.w;
  }
  const int n = n0 + r;
  if (which == 0) {
    float ss = 0.f;
#pragma unroll
    for (int e = 0; e < 8; ++e) ss += o[e] * o[e];
    ss += __shfl_xor(ss, 1); ss += __shfl_xor(ss, 2); ss += __shfl_xor(ss, 4);
    const float rs = rsqrtf(ss * (1.f / 64.f) + EPS);
#pragma unroll
    for (int e = 0; e < 8; ++e) o[e] = o[e] * rs * p.d_knorm[e0 + e];
    const float* cs = p.rope8 + (16 * min(n, NCMP - 1) + 31) * 16;
    const int sub = tid & 7;
#pragma unroll
    for (int e = 0; e < 8; ++e) {
      const float other = __shfl_xor(o[e], 1);
      if (sub == 0) o[e] = o[e] * cs[e] - other * cs[8 + e];
      else if (sub == 1) o[e] = other * cs[8 + e] + o[e] * cs[e];
    }
    if (n >= NCMP) {
#pragma unroll
      for (int e = 0; e < 8; ++e) o[e] = 0.f;
    }
    st8(p.kc + ((size_t)((b * 2 + g) * 256 + n)) * 64 + e0, o);
  } else {
#pragma unroll
    for (int e = 0; e < 8; ++e)
      p.vcT[((size_t)((b * 2 + g) * 64 + e0 + e)) * 256 + ((n & ~15) | ((n & 4) << 1) | ((n & 8) >> 1) | (n & 3))] = (n >= NCMP) ? (u16)0 : f2bf(o[e]);
  }
}

template <bool EDGE>
DI void conv_pass(const Params& p, const u16* base, int t0, int c, float* ys, float (&ssq)[16]) {
  float hv[46];
#pragma unroll
  for (int r = 0; r < 46; ++r) {
    const int ts = t0 - 30 + r;
    if (EDGE) hv[r] = ts >= 0 ? bf2f(base[(size_t)ts * LDP + c]) * sigmoidf_(bf2f(base[(size_t)ts * LDP + (C_B - C_A) + c])) : 0.f;
    else hv[r] = bf2f(base[(size_t)ts * LDP + c]) * sigmoidf_(bf2f(base[(size_t)ts * LDP + (C_B - C_A) + c]));
  }
  float y[16];
  const float bias = p.conv_b[c];
#pragma unroll
  for (int i = 0; i < 16; ++i) y[i] = bias;
#pragma unroll
  for (int j = 0; j < 31; ++j) {
    const float wv = p.conv_w[j * 512 + c];
#pragma unroll
    for (int i = 0; i < 16; ++i) y[i] += hv[i + j] * wv;
  }
#pragma unroll
  for (int i = 0; i < 16; ++i) { ssq[i] += y[i] * y[i]; ys[i * 512 + c] = y[i]; }
}
DI void conv_item2(const Params& p, int item, float* smf) {
  const int tt = item & 255, b = item >> 8;
  const int t0 = tt * 16, tid = threadIdx.x, lane = tid & 63, w = tid >> 6;
  const u16* base = p.proj + (size_t)(b * SEQ) * LDP + C_A;
  float* ys = smf;
  float* red = smf + 16 * 512;
  float ssq[16];
#pragma unroll
  for (int i = 0; i < 16; ++i) ssq[i] = 0.f;
  __syncthreads();
#pragma unroll 1
  for (int cc = 0; cc < 2; ++cc) {
    const int c = tid + cc * 256;
    if (t0 >= 32) conv_pass<false>(p, base, t0, c, ys, ssq);
    else conv_pass<true>(p, base, t0, c, ys, ssq);
  }
#pragma unroll
  for (int i = 0; i < 16; ++i) ssq[i] = wsum(ssq[i]);
  if (lane == 0) {
#pragma unroll
    for (int i = 0; i < 16; ++i) red[w * 16 + i] = ssq[i];
  }
  __syncthreads();
  float rsv[16];
#pragma unroll
  for (int i = 0; i < 16; ++i) rsv[i] = rsqrtf((red[i] + red[16 + i] + red[32 + i] + red[48 + i]) * (1.f / 512.f) + EPS);
#pragma unroll 1
  for (int cc = 0; cc < 2; ++cc) {
    const int c = tid + cc * 256;
    const float cn = p.c_norm[c];
    u16 gtv[16];
#pragma unroll
    for (int i = 0; i < 16; ++i) gtv[i] = p.proj[((size_t)b * SEQ + t0 + i) * LDP + C_G + c];
#pragma unroll
    for (int i = 0; i < 16; ++i) {
      const float yy = siluf_(ys[i * 512 + c] * rsv[i] * cn);
      p.ycat[((size_t)b * SEQ + t0 + i) * MIX + c] = f2bf(yy * siluf_(bf2f(gtv[i])));
    }
  }
}

constexpr int HLD = 264;
DI void conv_item4(const Params& p, int item, float* smf) {
  const int tt = item & 255, b = item >> 8;
  const int t0 = tt * 16, tid = threadIdx.x, lane = tid & 63, w = tid >> 6;
  const u16* base = p.proj + (size_t)(b * SEQ) * LDP + C_A;
  u16* hs = (u16*)smf;
  float* red = smf + (46 * HLD * 2 + 15) / 16 * 4;
  float yA[16], yB[16];
  float ssq[16];
#pragma unroll
  for (int i = 0; i < 16; ++i) ssq[i] = 0.f;
#pragma unroll 1
  for (int half = 0; half < 2; ++half) {
    __syncthreads();
#pragma unroll 2
    for (int it = 0; it < 6; ++it) {
      const int ci = tid + it * 256;
      if (ci < 46 * 32) {
        const int r = ci >> 5, c8 = (ci & 31) * 8;
        const int ts = t0 - 30 + r, tsc = ts > 0 ? ts : 0;
        float av[8], bv[8];
        ld8(base + (size_t)tsc * LDP + half * 256 + c8, av);
        ld8(base + (size_t)tsc * LDP + (C_B - C_A) + half * 256 + c8, bv);
#pragma unroll
        for (int e = 0; e < 8; ++e) av[e] = ts >= 0 ? av[e] * sigmoidf_(bv[e]) : 0.f;
        st8(hs + r * HLD + c8, av);
      }
    }
    __syncthreads();
    const int c = half * 256 + tid;
    float hv[46];
#pragma unroll
    for (int r = 0; r < 46; ++r) hv[r] = bf2f(hs[r * HLD + tid]);
    const float bias = p.conv_b[c];
    float yy[16];
#pragma unroll
    for (int i = 0; i < 16; ++i) yy[i] = bias;
#pragma unroll
    for (int j = 0; j < 31; ++j) {
      const float wv = p.conv_w[j * 512 + c];
#pragma unroll
      for (int i = 0; i < 16; ++i) yy[i] += hv[i + j] * wv;
    }
#pragma unroll
    for (int i = 0; i < 16; ++i) { ssq[i] += yy[i] * yy[i]; if (half == 0) yA[i] = yy[i]; else yB[i] = yy[i]; }
  }
#pragma unroll
  for (int i = 0; i < 16; ++i) ssq[i] = wsum(ssq[i]);
  if (lane == 0) {
#pragma unroll
    for (int i = 0; i < 16; ++i) red[w * 16 + i] = ssq[i];
  }
  __syncthreads();
  float rsv[16];
#pragma unroll
  for (int i = 0; i < 16; ++i) rsv[i] = rsqrtf((red[i] + red[16 + i] + red[32 + i] + red[48 + i]) * (1.f / 512.f) + EPS);
#pragma unroll 1
  for (int half = 0; half < 2; ++half) {
    const int c = half * 256 + tid;
    const float cn = p.c_norm[c];
    u16 gtv[16];
#pragma unroll
    for (int i = 0; i < 16; ++i) gtv[i] = p.proj[((size_t)b * SEQ + t0 + i) * LDP + C_G + c];
#pragma unroll
    for (int i = 0; i < 16; ++i) {
      const float yy = siluf_((half ? yB[i] : yA[i]) * rsv[i] * cn);
      p.ycat[((size_t)b * SEQ + t0 + i) * MIX + c] = f2bf(yy * siluf_(bf2f(gtv[i])));
    }
  }
}

template <int L>
DI float group_rs(const float* v) {
  float ss = 0.f;
#pragma unroll
  for (int i = 0; i < 8; ++i) ss += v[i] * v[i];
#pragma unroll
  for (int o = 1; o < L; o <<= 1) ss += __shfl_xor(ss, o);
  return rsqrtf(ss * (1.f / (8.f * L)) + EPS);
}

DI void prep0_token(const Params& p, int tok, int lane) {
  u16* row = p.proj + (size_t)tok * LDP;
  const int t = tok & (SEQ - 1);
  float v[8];
#pragma unroll
  for (int which = 0; which < 2; ++which) {
    u16* ptr = row + (which ? B_K : B_Q) + lane * 8;
    const float* g = which ? p.b_knorm : p.b_qnorm;
    ld8(ptr, v);
    float rs = group_rs<4>(v);
#pragma unroll
    for (int i = 0; i < 8; ++i) v[i] = v[i] * rs * g[(lane & 3) * 8 + i];
    if ((lane & 3) == 0) {
      const float* cs = p.rope4 + t * 8;
#pragma unroll
      for (int i = 0; i < 4; ++i) {
        float x1 = v[i], x2 = v[4 + i], c = cs[i], s = cs[4 + i];
        v[i] = x1 * c - x2 * s; v[4 + i] = x1 * s + x2 * c;
      }
    }
    if (which) st8(p.kd + ((size_t)((tok >> 12) * 8 + (lane >> 3)) * SEQ + t) * 64 + (lane & 7) * 8, v);
    else st8(ptr, v);
  }
  {
    u16* ptr = row + A_V + lane * 8;
    ld8(ptr, v);
#pragma unroll
    for (int i = 0; i < 8; ++i) v[i] = geluf_(v[i]);
    float rs = group_rs<16>(v);
#pragma unroll
    for (int i = 0; i < 8; ++i) v[i] = v[i] * rs * p.a_vnorm[lane * 8 + i];
    st8(ptr, v);
  }
  {
    const int l2 = lane & 31;
    u16* ptr = row + M0_Q + l2 * 8;
    ld8(ptr, v);
    float rs = group_rs<8>(v);
#pragma unroll
    for (int i = 0; i < 8; ++i) v[i] = v[i] * rs * p.m0_qnorm[(l2 & 7) * 8 + i];
    if (lane < 32) st8(ptr, v);
  }
}

DI void memk_norm_row(u16* rowp, const float* g, int lane) {
  float v[8];
  const int l2 = lane & 31;
  u16* ptr = rowp + l2 * 8;
  ld8(ptr, v);
  float rs = group_rs<8>(v);
#pragma unroll
  for (int i = 0; i < 8; ++i) v[i] = v[i] * rs * g[(l2 & 7) * 8 + i];
  if (lane < 32) st8(ptr, v);
}

DI void phase_prep0(const Params& p, u16* smem) {
  const int lane = threadIdx.x & 63, w = threadIdx.x >> 6;
  const int n_row = (T + 2048) / 4, n_vt = BATCH * 8 * 64, n_mvt = 2 * BATCH * 4 * 4;
  for (int it = blockIdx.x; it < n_row + n_vt + n_mvt; it += gridDim.x) {
    if (it < n_vt) {
      const int tt = it & 63, bh = it >> 6;
      const int b = bh >> 3, h = bh & 7;
      transpose64(p.proj + (size_t)(b * SEQ + tt * 64) * LDP + B_V + h * 64, LDP, p.vT + (size_t)(bh * 64 + tt) * 4096, 64, smem);
    } else if (it < n_vt + n_mvt) {
      int e = it - n_vt;
      const int mt = e & 3; e >>= 2;
      const int h = e & 3; e >>= 2;
      const int b = e & 3; e >>= 2;
      const int l = e;
      transpose64((l ? p.memkv1 : p.memkv0) + (size_t)(b * 256 + mt * 64) * 512 + 256 + h * 64, 512,
                  (l ? p.memvT1 : p.memvT0) + (size_t)((b * 4 + h) * 64) * 256 + mt * 64, 256, smem);
    } else {
      int r = (it - n_vt - n_mvt) * 4 + w;
      if (r < T) prep0_token(p, r, lane);
      else {
        r -= T;
        if (r < 1024) memk_norm_row(p.memkv0 + (size_t)r * 512, p.m0_knorm, lane);
        else memk_norm_row(p.memkv1 + (size_t)(r - 1024) * 512, p.m1_knorm, lane);
      }
    }
  }
}

DI void prep1_token(const Params& p, int tok, int lane) {
  u16* row = p.proj + (size_t)tok * LDP;
  const int t = tok & (SEQ - 1);
  const float* cs = p.rope8 + t * 16;
  float v[8];
  {
    u16* ptr = row + D_Q + lane * 8;
    ld8(ptr, v);
    float rs = group_rs<8>(v);
#pragma unroll
    for (int i = 0; i < 8; ++i) v[i] = v[i] * rs * p.d_qnorm[(lane & 7) * 8 + i];
    const int sub = lane & 7;
#pragma unroll
    for (int i = 0; i < 8; ++i) {
      float other = __shfl_xor(v[i], 1);
      float c = cs[i], s = cs[8 + i];
      if (sub == 0) v[i] = v[i] * c - other * s;
      else if (sub == 1) v[i] = other * s + v[i] * c;
    }
    st8(ptr, v);
  }
  {
    int col = lane < 16 ? (D_KV + 2 * 128 + lane * 8) : lane < 32 ? (D_KV + 4 * 128 + (lane - 16) * 8) : (M1_Q + (lane - 32) * 8);
    const float* g = lane < 32 ? p.d_knorm : p.m1_qnorm;
    u16* ptr = row + col;
    ld8(ptr, v);
    float rs = group_rs<8>(v);
#pragma unroll
    for (int i = 0; i < 8; ++i) v[i] = v[i] * rs * g[(lane & 7) * 8 + i];
    const int sub = lane & 7;
#pragma unroll
    for (int i = 0; i < 8; ++i) {
      float other = __shfl_xor(v[i], 1);
      float c = cs[i], s = cs[8 + i];
      if (lane < 32) {
        if (sub == 0) v[i] = v[i] * c - other * s;
        else if (sub == 1) v[i] = other * s + v[i] * c;
      }
    }
    if (lane < 32) st8((lane < 16 ? p.ksd : p.kwd) + ((size_t)((tok >> 12) * 2 + ((lane >> 3) & 1)) * SEQ + t) * 64 + (lane & 7) * 8, v);
    else st8(ptr, v);
  }
  {
    float b[8];
    u16* ptr = row + C_A + lane * 8;
    ld8(ptr, v);
    ld8(row + C_B + lane * 8, b);
#pragma unroll
    for (int i = 0; i < 8; ++i) v[i] = v[i] * sigmoidf_(b[i]);
    st8(ptr, v);
  }
}

DI void compress_item(const Params& p, int item, float* smf) {
  const int nch = item & 31; item >>= 5;
  const int g = item & 1; item >>= 1;
  const int b = item & 3; item >>= 2;
  const int which = item;
  const float* w1 = which ? p.w1_v : p.w1_k;
  const float* w2 = which ? p.w2_v : p.w2_k;
  const int col = D_KV + which * 128 + g * 64;
  const int tid = threadIdx.x, j = tid & 127, kh = tid >> 7;
  const int n0 = nch * 8;
  float acc[8];
#pragma unroll
  for (int i = 0; i < 8; ++i) acc[i] = 0.f;
  const u16* base = p.proj + (size_t)(b * SEQ) * LDP + col;
  for (int kk = 0; kk < 1024; ++kk) {
    const int k = kh * 1024 + kk, l = k >> 6, d = k & 63;
    const float wv = w1[k * 128 + j];
#pragma unroll
    for (int i = 0; i < 8; ++i) {
      int n = n0 + i; if (n > NCMP - 1) n = NCMP - 1;
      acc[i] += bf2f(base[(size_t)(16 * n + l) * LDP + d]) * wv;
    }
  }
  float* hid = smf;
  float* outb = smf + 2048;
  __syncthreads();
#pragma unroll
  for (int i = 0; i < 8; ++i) hid[(kh * 8 + i) * 128 + j] = acc[i];
  __syncthreads();
  for (int e = tid; e < 1024; e += 256) {
    float s = hid[e] + hid[1024 + e];
    for (int l = 0; l < 32; ++l) s += p.cbias[(which * 32 + l) * 128 + (e & 127)];
    hid[e] = siluf_(s);
  }
  __syncthreads();
  for (int e = tid; e < 512; e += 256) {
    const int i = e >> 6, c = e & 63;
    float a = 0.f;
    for (int jj = 0; jj < 128; ++jj) a += hid[i * 128 + jj] * w2[jj * 64 + c];
    outb[e] = a;
  }
  __syncthreads();
  const int lane = tid & 63, w = tid >> 6;
  for (int i = w; i < 8; i += 4) {
    const int n = n0 + i;
    float y = outb[i * 64 + lane];
    u16* dst = which ? (p.vcT + ((size_t)((b * 2 + g) * 64 + lane)) * 256 + n) : (p.kc + ((size_t)((b * 2 + g) * 256 + n)) * 64 + lane);
    if (n >= NCMP) { *dst = 0; continue; }
    if (which == 0) {
      float ss = wsum(y * y);
      y = y * rsqrtf(ss * (1.f / 64.f) + EPS) * p.d_knorm[lane];
      float other = __shfl_xor(y, 8);
      const float* cs = p.rope8 + (16 * n + 31) * 16;
      if (lane < 8) y = y * cs[lane] - other * cs[8 + lane];
      else if (lane < 16) y = other * cs[8 + lane - 8] + y * cs[lane - 8];
    }
    *dst = f2bf(y);
  }
}

DI void phase_prep1(const Params& p, float* smf) {
  const int lane = threadIdx.x & 63, w = threadIdx.x >> 6;
  const int n_tok = T / 4, n_cmp = 2 * 4 * 2 * 8, n_vt = 2 * 8 * 64;
  for (int it = blockIdx.x; it < n_tok + n_cmp + n_vt; it += gridDim.x) {
    if (it < n_cmp) compress_item_mfma(p, it, smf);
    else if (it < n_cmp + n_vt) {
      int e = it - n_cmp;
      const int tt = e & 63; e >>= 6;
      const int bg = e & 7; e >>= 3;
      const int which = e;
      transpose64(p.proj + (size_t)((bg >> 1) * SEQ + tt * 64) * LDP + D_KV + (which ? 5 : 3) * 128 + (bg & 1) * 64, LDP,
                  (which ? p.vwT : p.vsT) + (size_t)(bg * 64 + tt) * 4096, 64, (u16*)smf);
    }
    else prep1_token(p, (it - n_cmp - n_vt) * 4 + w, lane);
  }
}

struct OS { float m, l, acc; };
template <int DK>
DI void os_chunk(OS& st, const float* q, bool valid, const u16* krow, const u16* vbase, int vstride, float scale,
                 float* p_lds, int lane) {
  float s = -INFINITY;
  if (valid) {
    float a = 0.f;
#pragma unroll
    for (int c = 0; c < DK / 8; ++c) {
      float kv[8];
      ld8(krow + c * 8, kv);
#pragma unroll
      for (int i = 0; i < 8; ++i) a += q[c * 8 + i] * kv[i];
    }
    s = a * scale;
  }
  float cm = wmax(s);
  if (cm == -INFINITY) return;
  float mn = fmaxf(st.m, cm);
  float pe = valid ? __expf(s - mn) : 0.f;
  float corr = __expf(st.m - mn);
  st.l = st.l * corr + wsum(pe);
  st.acc *= corr;
  st.m = mn;
  wave_sync();
  p_lds[lane] = pe;
  wave_sync();
  float a = st.acc;
#pragma unroll 8
  for (int jj = 0; jj < 64; ++jj) a += p_lds[jj] * bf2f(vbase[(size_t)jj * vstride + lane]);
  st.acc = a;
}

template <int DK>
DI void load_q(const u16* ptr, float* q) {
#pragma unroll
  for (int c = 0; c < DK / 8; ++c) ld8(ptr + c * 8, q + c * 8);
}

DI void diffattn_wave(const Params& p, int b, int h, int t, float lam, float* p_lds, int lane) {
  const int tok = b * SEQ + t;
  const u16* base = p.proj + (size_t)(b * SEQ) * LDP;
  float o[2];
#pragma unroll
  for (int m = 0; m < 2; ++m) {
    float q[32];
    load_q<32>(p.proj + (size_t)tok * LDP + B_Q + (h * 2 + m) * 32, q);
    OS st{-INFINITY, 0.f, 0.f};
    const int nch = t / 64 + 1;
    for (int c = 0; c < nch; ++c) {
      const int pos = c * 64 + lane;
      os_chunk<32>(st, q, pos <= t, base + (size_t)pos * LDP + B_K + (h * 2 + m) * 32,
                   base + (size_t)(c * 64) * LDP + B_V + h * 64, LDP, 0.17677669529663687f, p_lds, lane);
    }
    o[m] = st.acc / st.l;
  }
  float od = o[0] - lam * o[1];
  float ss = wsum(od * od);
  const float lam_init = 0.8f - 0.6f * 0.7408182206817179f;
  float y = od * rsqrtf(ss * (1.f / 64.f) + EPS) * p.b_subln[lane] * (1.f - lam_init);
  float gate = bf2f(p.proj[(size_t)tok * LDP + B_G + h * 64 + lane]);
  p.ycat[(size_t)tok * MIX + 512 + h * 64 + lane] = f2bf(y * siluf_(gate));
}

DI void memattn_wave(const Params& p, int layer, int b, int h, int t, float* p_lds, int lane) {
  const int tok = b * SEQ + t;
  const int qcol = layer ? M1_Q : M0_Q, gcol = layer ? M1_G : M0_G;
  const u16* kv = (layer ? p.memkv1 : p.memkv0) + (size_t)(b * 256) * 512;
  float q[64];
  load_q<64>(p.proj + (size_t)tok * LDP + qcol + h * 64, q);
  OS st{-INFINITY, 0.f, 0.f};
  for (int c = 0; c < 4; ++c) {
    const int m = c * 64 + lane;
    os_chunk<64>(st, q, true, kv + (size_t)m * 512 + h * 64, kv + (size_t)(c * 64) * 512 + 256 + h * 64, 512, 0.125f, p_lds, lane);
  }
  float o = st.acc / st.l;
  float gate = bf2f(p.proj[(size_t)tok * LDP + gcol + h * 64 + lane]);
  p.ycat[(size_t)tok * MIX + 1024 + h * 64 + lane] = f2bf(o * siluf_(gate));
}

DI void sgu_item(const Params& p, int item, u16* smem) {
  const int g = item & 3; item >>= 2;
  const int c = item & 31; item >>= 5;
  const int b = item;
  const int tok0 = b * SEQ + c * 128;
  const int tid = threadIdx.x;
  __syncthreads();
  for (int i = tid; i < 2048; i += 256) {
    int s = i >> 4, c8 = i & 15;
    *(uint4*)(smem + s * 128 + c8 * 8) = *(const uint4*)(p.proj + (size_t)(tok0 + s) * LDP + A_V + g * 128 + c8 * 8);
  }
  __syncthreads();
  const int d = tid & 127, th = tid >> 7;
  const float* W = p.a_ws + g * 128 * 128;
  for (int t = th; t < 128; t += 2) {
    float a = 0.f;
    for (int s = 0; s <= t; ++s) a += W[t * 128 + s] * bf2f(smem[s * 128 + d]);
    float z = a + p.a_bs[g * 128 + t];
    const u16* row = p.proj + (size_t)(tok0 + t) * LDP;
    float u = geluf_(bf2f(row[A_U + g * 128 + d]));
    float gt = siluf_(bf2f(row[A_G + g * 128 + d]));
    p.ycat[(size_t)(tok0 + t) * MIX + g * 128 + d] = f2bf(u * z * gt);
  }
}

DI void phase_mix0(const Params& p, u16* smem, int* qslot) {
  const int lane = threadIdx.x & 63, w = threadIdx.x >> 6;
  float* p_lds = (float*)smem + 8192 + w * 64;
  float a1 = lane < 32 ? p.lq1[lane] * p.lk1[lane] : 0.f;
  float a2 = lane < 32 ? p.lq2[lane] * p.lk2[lane] : 0.f;
  const float lam_init = 0.8f - 0.6f * 0.7408182206817179f;
  const float lam = expf(wsum(a1)) - expf(wsum(a2)) + lam_init;
  const int n_diff = BATCH * 8 * 32, n_sgu = BATCH * 32 * 4, n_mem = BATCH * 4 * 32;
  const int G = gridDim.x;
  (void)G;
  unsigned* ctr = p.qctr;
  int it = blockIdx.x;
  while (it < n_diff) {
    const int qt = 31 - it / 32, bh = it % 32;
    diffattn_item(p, bh >> 3, bh & 7, qt, lam, smem);
    it = queue_pull(ctr, qslot);
  }
  while (it < n_diff + n_sgu) { sgu_item_mfma(p, it - n_diff, smem); it = queue_pull(ctr, qslot); }
  while (it < n_diff + n_sgu + n_mem) {
    const int e = it - n_diff - n_sgu;
    memattn_item(p, 0, (e >> 2) & 3, e & 3, e >> 4, smem);
    it = queue_pull(ctr, qslot);
  }
}

DI void conv_item(const Params& p, int item, float* smf) {
  const int tt = item & 255, b = item >> 8;
  const int t0 = tt * 16, tid = threadIdx.x;
  const u16* base = p.proj + (size_t)(b * SEQ) * LDP + C_A;
  __syncthreads();
#pragma unroll 1
  for (int cc = 0; cc < 2; ++cc) {
    const int c = tid + cc * 256;
    float wv[31];
#pragma unroll
    for (int j = 0; j < 31; ++j) wv[j] = p.conv_w[j * 512 + c];
    const float bias = p.conv_b[c];
#pragma unroll 1
    for (int i = 0; i < 16; ++i) {
      const int t = t0 + i;
      float a = bias;
#pragma unroll
      for (int j = 0; j < 31; ++j) {
        int ts = t - 30 + j;
        float hv = ts >= 0 ? bf2f(base[(size_t)ts * LDP + c]) : 0.f;
        a += hv * wv[j];
      }
      smf[i * 512 + c] = a;
    }
  }
  __syncthreads();
  const int lane = tid & 63, w = tid >> 6;
  for (int i = w; i < 16; i += 4) {
    const int tok = b * SEQ + t0 + i;
    float v[8], ss = 0.f;
#pragma unroll
    for (int e = 0; e < 8; ++e) { v[e] = smf[i * 512 + e * 64 + lane]; ss += v[e] * v[e]; }
    ss = wsum(ss);
    float rs = rsqrtf(ss * (1.f / 512.f) + EPS);
#pragma unroll
    for (int e = 0; e < 8; ++e) {
      int c = e * 64 + lane;
      float y = siluf_(v[e] * rs * p.c_norm[c]);
      float gt = siluf_(bf2f(p.proj[(size_t)tok * LDP + C_G + c]));
      p.ycat[(size_t)tok * MIX + c] = f2bf(y * gt);
    }
  }
}

DI void nsa_wave(const Params& p, int b, int t, int g, float* wl  , int lane) {
  const int tok = b * SEQ + t;
  const u16* prow = p.proj + (size_t)tok * LDP;
  const u16* base = p.proj + (size_t)(b * SEQ) * LDP;
  const u16* kcb = p.kc + (size_t)((b * 2 + g) * 256) * 64;
  const u16* vcb = p.vc + (size_t)((b * 2 + g) * 256) * 64;
  float* p_lds = wl;
  float* ps_lds = wl + 64;
  float psum[4] = {0.f, 0.f, 0.f, 0.f};
  float oc[4];
  const int nvc = t >= 31 ? min((t - 31) / 16 + 1, NCMP) : 0;
  oc[0] = oc[1] = oc[2] = oc[3] = 0.f;
#pragma unroll 1
  for (int r = 0; r < 4; ++r) {
    const int h = g * 4 + r;
    float q[64];
    load_q<64>(prow + D_Q + h * 64, q);
    float s[4] = {-INFINITY, -INFINITY, -INFINITY, -INFINITY};
    float mx = -INFINITY;
#pragma unroll 1
    for (int i = 0; i < 4; ++i) {
      const int n = lane + 64 * i;
      float sv = -INFINITY;
      if (n < nvc) {
        float a = 0.f;
#pragma unroll
        for (int c = 0; c < 8; ++c) {
          float kv[8];
          ld8(kcb + n * 64 + c * 8, kv);
#pragma unroll
          for (int e = 0; e < 8; ++e) a += q[c * 8 + e] * kv[e];
        }
        sv = a * 0.125f;
      }
      if (i == 0) s[0] = sv; else if (i == 1) s[1] = sv; else if (i == 2) s[2] = sv; else s[3] = sv;
      mx = fmaxf(mx, sv);
    }
    mx = wmax(mx);
    float e4[4], sum = 0.f;
#pragma unroll
    for (int i = 0; i < 4; ++i) { e4[i] = (s[i] > -INFINITY) ? __expf(s[i] - mx) : 0.f; sum += e4[i]; }
    sum = wsum(sum);
    const float inv = 1.f / fmaxf(sum, 1.17549435e-38f);
    float acc = 0.f;
#pragma unroll
    for (int i = 0; i < 4; ++i) {
      const float pr = e4[i] * inv;
      psum[i] += pr;
      if (i * 64 < nvc) {
        wave_sync();
        p_lds[lane] = pr;
        wave_sync();
        for (int jj = 0; jj < 64; ++jj) acc += p_lds[jj] * bf2f(vcb[(size_t)(i * 64 + jj) * 64 + lane]);
      }
    }
    if (r == 0) oc[0] = acc; else if (r == 1) oc[1] = acc; else if (r == 2) oc[2] = acc; else oc[3] = acc;
  }
  wave_sync();
#pragma unroll
  for (int i = 0; i < 4; ++i) ps_lds[lane + 64 * i] = psum[i];
  wave_sync();
  float imp = ps_lds[4 * lane] + ps_lds[4 * lane + 1] + ps_lds[4 * lane + 2] + 0.5f * ps_lds[4 * lane + 3];
  if (lane > 0) imp += 0.5f * ps_lds[4 * lane - 1];
  const int cur = t >> 6;
  if (lane > cur) imp = -INFINITY;
  if (lane == 0 || lane == cur || lane == cur - 1) imp = INFINITY;
  int cnt = 0;
  for (int jj = 0; jj < 64; ++jj) {
    float v = __shfl(imp, jj);
    cnt += (v > imp || (v == imp && jj < lane)) ? 1 : 0;
  }
  u64 msk = __ballot(cnt < 16 && lane <= cur);
#pragma unroll 1
  for (int r = 0; r < 4; ++r) {
    const int h = g * 4 + r;
    float q[64];
    load_q<64>(prow + D_Q + h * 64, q);
    OS ss{-INFINITY, 0.f, 0.f};
    u64 mm = msk;
    while (mm) {
      const int j = __ffsll((long long)mm) - 1; mm &= mm - 1;
      const int pos = j * 64 + lane;
      os_chunk<64>(ss, q, pos <= t, base + (size_t)pos * LDP + D_KV + 2 * 128 + g * 64,
                   base + (size_t)(j * 64) * LDP + D_KV + 3 * 128 + g * 64, LDP, 0.125f, p_lds, lane);
    }
    const float o_s = ss.l > 0.f ? ss.acc / ss.l : 0.f;
    OS sw{-INFINITY, 0.f, 0.f};
    const int lo = max(t - 511, 0);
    for (int c = lo >> 6; c <= cur; ++c) {
      const int pos = c * 64 + lane;
      os_chunk<64>(sw, q, pos <= t && pos >= lo, base + (size_t)pos * LDP + D_KV + 4 * 128 + g * 64,
                   base + (size_t)(c * 64) * LDP + D_KV + 5 * 128 + g * 64, LDP, 0.125f, p_lds, lane);
    }
    const float o_w = sw.l > 0.f ? sw.acc / sw.l : 0.f;
    const float gc = sigmoidf_(bf2f(prow[D_BG + h * 3 + 0]));
    const float gs = sigmoidf_(bf2f(prow[D_BG + h * 3 + 1]));
    const float gw = sigmoidf_(bf2f(prow[D_BG + h * 3 + 2]));
    const float ocr = r == 0 ? oc[0] : r == 1 ? oc[1] : r == 2 ? oc[2] : oc[3];
    const float o = gc * ocr + gs * o_s + gw * o_w;
    const float gate = bf2f(prow[D_G + h * 64 + lane]);
    p.ycat[(size_t)tok * MIX + 512 + h * 64 + lane] = f2bf(o * siluf_(gate));
  }
}

DI void nsa_item(const Params& p, int b, int g, int qt, u16* smem) {
  const int lane = threadIdx.x & 63, w = threadIdx.x >> 6, l31 = lane & 31, hh = lane >> 5;
  const int q0 = qt * 32, wq0 = q0 + 8 * w, qi = l31 & 7, myq = wq0 + qi;
  const int h = g * 4 + (l31 >> 3);
  const size_t tok = (size_t)b * SEQ + myq;
  const u16* prow = p.proj + tok * LDP;
  float* impW = (float*)(smem + 2 * KV_BUF) + w * (8 * 65);
  u64* Ush = (u64*)((float*)(smem + 2 * KV_BUF) + 4 * 8 * 65);
  bf16x8 qf[4];
#pragma unroll
  for (int ks = 0; ks < 4; ++ks) qf[ks] = *(const bf16x8*)(prow + D_Q + h * 64 + ks * 16 + hh * 8);
  const float c = 0.125f * 1.4426950408889634f;
#pragma unroll
  for (int ks = 0; ks < 4; ++ks) qf[ks] = scale_frag(qf[ks], c);
  const bf16x8 aone = frag_first(1.f, hh);
  const bf16x8 qx = frag_first(-8.f * 1.01f * gain_absmax(p.d_knorm, 64, lane) * sqrtf(q_norm2<4>(qf)), hh);
  const bf16x8 qxoff = frag_first(-INFINITY, hh);
  const u16 gate_c = prow[D_BG + h * 3 + 0], gate_s = prow[D_BG + h * 3 + 1], gate_w = prow[D_BG + h * 3 + 2];
  f32x16 outacc[2];
  const u16* kcb = p.kc + (size_t)((b * 2 + g) * 256) * 64;
  const u16* vctb = p.vcT + (size_t)((b * 2 + g) * 64) * 256;
  const int hi_c = (myq >= 31) ? ((myq - 31) >> 4) : -1;
  const int nct = (q0 >> 10) + 1;
  float l1 = 0.f;
  kv_pipeline(nct, smem,
    [&](int j, const u16*& kp, int& ks, const u16*& vp, int& vs) { kp = kcb + (size_t)(j * 64) * 64; ks = 64; vp = vctb + j * 64; vs = 256; },
    [&](int j, const u16* Ks, const u16* Vt) {
      f32x16 s[2];
      fa_scores<64>(s, qf, Ks, l31, hh, aone, qx);
      fa_mask(s, j * 64, 0, hi_c, hh);
      float rs = 0.f;
#pragma unroll
      for (int sub = 0; sub < 2; ++sub)
#pragma unroll
        for (int i = 0; i < 16; ++i) rs += __builtin_amdgcn_exp2f(s[sub][i]);
      l1 += rs;
    });
  l1 += __shfl_xor(l1, 32);
  {
    FAState stc; fa_init(stc);
    const float il = l1 > 0.f ? 1.f / l1 : 0.f;
    float prevy = 0.f;
    kv_pipeline(nct, smem,
      [&](int j, const u16*& kp, int& ks, const u16*& vp, int& vs) { kp = kcb + (size_t)(j * 64) * 64; ks = 64; vp = vctb + j * 64; vs = 256; },
      [&](int j, const u16* Ks, const u16* Vt) {
        f32x16 s[2];
        fa_scores<64>(s, qf, Ks, l31, hh, aone, qx);
        fa_mask(s, j * 64, 0, hi_c, hh);
#pragma unroll
        for (int sub = 0; sub < 2; ++sub)
#pragma unroll
          for (int i = 0; i < 16; ++i) s[sub][i] = __builtin_amdgcn_exp2f(s[sub][i]) * il;
        bf16x8 pf[4];
#pragma unroll
        for (int ks = 0; ks < 4; ++ks) pf[ks] = pack8(s[ks >> 1], (ks & 1) * 8);
        fa_pv(stc, pf, Vt, l31, hh);
#pragma unroll
        for (int a = 0; a < 8; ++a) {
          const int sub = a >> 2, r4 = (a & 3) * 4;
          const float p3 = s[sub][r4 + 3];
          const float y = __shfl_xor(p3, 32);
          float A = s[sub][r4] + s[sub][r4 + 1] + s[sub][r4 + 2] + 0.5f * p3 + 0.5f * (hh ? y : prevy);
          prevy = y;
          A += __shfl_xor(A, 8);
          A += __shfl_xor(A, 16);
          if (l31 < 8) impW[qi * 65 + 16 * j + 2 * a + hh] = A;
        }
      });
    const float gc = sigmoidf_(bf2f(gate_c));
#pragma unroll
    for (int i = 0; i < 16; ++i) { outacc[0][i] = gc * stc.o[0][i]; outacc[1][i] = gc * stc.o[1][i]; }
  }
  wave_sync();
  u64 mymsk = 0, Uw = 0;
#pragma unroll 1
  for (int q8 = 0; q8 < 8; ++q8) {
    const int cur = (wq0 + q8) >> 6;
    float imp = impW[q8 * 65 + lane];
    if (lane == 0 || lane == cur || lane == cur - 1) imp = INFINITY;
    unsigned key = (__float_as_uint(imp) & ~63u) | (unsigned)(63 - lane);
    if (lane > cur) key = 0u;
    unsigned thr = 0u;
#pragma unroll
    for (int bit = 31; bit >= 0; --bit) {
      const unsigned cand = thr | (1u << bit);
      if (__popcll(__ballot(key >= cand)) >= 16) thr = cand;
    }
    const u64 bal = __ballot(key >= thr && lane <= cur);
    if (qi == q8) mymsk = bal;
    Uw |= bal;
  }
  __syncthreads();
  if (lane == 0) Ush[w] = Uw;
  __syncthreads();
  const u64 Ub = Ush[0] | Ush[1] | Ush[2] | Ush[3];
  {
    FAState st; fa_init(st);
    const u16* vtb = p.vsT + (size_t)(b * 2 + g) * SEQ * 64;
    const u16* kb2 = p.proj + (size_t)(b * SEQ) * LDP + D_KV + 256 + g * 64;
    u64 remL = Ub, remC = Ub;
    kv_pipeline(__popcll(Ub), smem,
      [&](int t, const u16*& kp, int& ks, const u16*& vp, int& vs) {
        const int j = __ffsll((long long)remL) - 1; remL &= remL - 1;
        kp = kb2 + (size_t)(j * 64) * LDP; ks = LDP; vp = vtb + (size_t)j * 4096; vs = 64; },
      [&](int t, const u16* Ks, const u16* Vt) {
        const int j = __ffsll((long long)remC) - 1; remC &= remC - 1;
        if ((Uw >> j) & 1) {
          f32x16 s[2];
          fa_scores<64>(s, qf, Ks, l31, hh, aone, ((mymsk >> j) & 1) ? qx : qxoff);
          if (j * 64 + 63 > wq0) fa_mask(s, j * 64, 0, myq, hh);
          fa_softmax_pv(st, s, Vt, l31, hh);
        }
      });
    const float gs = sigmoidf_(bf2f(gate_s));
    const float ls = fa_rowsum(st);
    const float f = ls > 0.f ? gs / ls : 0.f;
#pragma unroll
    for (int i = 0; i < 16; ++i) { outacc[0][i] += f * st.o[0][i]; outacc[1][i] += f * st.o[1][i]; }
  }
  {
    FAState st; fa_init(st);
    const u16* vtb = p.vwT + (size_t)(b * 2 + g) * SEQ * 64;
    const u16* kb2 = p.proj + (size_t)(b * SEQ) * LDP + D_KV + 512 + g * 64;
    const int jlo = max(q0 - 511, 0) >> 6, jhi = (q0 + 31) >> 6;
    kv_pipeline(jhi - jlo + 1, smem,
      [&](int t, const u16*& kp, int& ks, const u16*& vp, int& vs) {
        const int j = jlo + t;
        kp = kb2 + (size_t)(j * 64) * LDP; ks = LDP; vp = vtb + (size_t)j * 4096; vs = 64; },
      [&](int t, const u16* Ks, const u16* Vt) {
        const int k0 = (jlo + t) * 64;
        if (k0 <= wq0 + 7 && k0 + 63 >= wq0 - 511) {
          f32x16 s[2];
          fa_scores<64>(s, qf, Ks, l31, hh, aone, qx);
          const bool need_mask = !(k0 >= wq0 + 7 - 511 && k0 + 63 <= wq0);
          if (need_mask) fa_mask(s, k0, myq - 511, myq, hh);
          fa_softmax_pv(st, s, Vt, l31, hh);
        }
      });
    const float gw = sigmoidf_(bf2f(gate_w));
    const float lw = fa_rowsum(st);
    const float f = lw > 0.f ? gw / lw : 0.f;
#pragma unroll
    for (int i = 0; i < 16; ++i) { outacc[0][i] += f * st.o[0][i]; outacc[1][i] += f * st.o[1][i]; }
  }
  uint2 gqs[2][4];
#pragma unroll
  for (int d = 0; d < 2; ++d)
#pragma unroll
    for (int a = 0; a < 4; ++a) gqs[d][a] = *(const uint2*)(prow + D_G + h * 64 + d * 32 + 8 * a + 4 * hh);
#pragma unroll
  for (int d = 0; d < 2; ++d)
#pragma unroll
    for (int a = 0; a < 4; ++a) {
      const int dim = d * 32 + 8 * a + 4 * hh;
      uint2 gq = gqs[d][a];
      float g0 = __uint_as_float(gq.x << 16), g1 = __uint_as_float(gq.x & 0xffff0000u);
      float g2 = __uint_as_float(gq.y << 16), g3 = __uint_as_float(gq.y & 0xffff0000u);
      uint2 o;
      o.x = pk_bf16(outacc[d][4 * a + 0] * siluf_(g0), outacc[d][4 * a + 1] * siluf_(g1));
      o.y = pk_bf16(outacc[d][4 * a + 2] * siluf_(g2), outacc[d][4 * a + 3] * siluf_(g3));
      *(uint2*)(p.ycat + tok * MIX + 512 + h * 64 + dim) = o;
    }
}

DI void phase_mix1(const Params& p, float* smf) {
  const int n_nsa = BATCH * 2 * 128, n_conv = BATCH * 256, n_mem = BATCH * 4 * 32;
  const int G = gridDim.x;
  const int total = n_nsa + n_conv + n_mem;
  const int total_r = ((total + G - 1) / G) * G;
  for (int it0 = blockIdx.x; it0 < total_r; it0 += G) {
    const int rnd = it0 / G;
    const int it = (rnd & 1) ? (rnd * G + (G - 1 - (it0 - rnd * G))) : it0;
    if (it >= total) continue;
    if (it < n_nsa) {
      const int qt = 127 - it / 8, bg = it % 8;
      nsa_item(p, bg >> 1, bg & 1, qt, (u16*)smf);
    } else if (it < n_nsa + n_conv) {
      conv_item2(p, it - n_nsa, smf);
    } else {
      const int e = it - n_nsa - n_conv;
      memattn_item(p, 1, (e >> 2) & 3, e & 3, e >> 4, (u16*)smf);
    }
  }
}

enum { K_PLAIN = 0, K_N32R4, K_GELU_N128, K_N64, K_N64R8, K_VT, K_VTM };
constexpr int CLD = 136;

DI void gemm_tile_fused(const u16* __restrict__ A, int lda, const u16* __restrict__ Bt, int ldb, int K, int m0, int n0, u16* smem,
                        int kind, u16* base, int ldc, int hb, int hbase, const float* gain, const Params& p) {
  const int tid = threadIdx.x, lane = tid & 63, w = tid >> 6;
  const int wm = w >> 1, wn = w & 1, l31 = lane & 31, hh = lane >> 5;
  f32x16 acc[2][2];
  gemm_mainloop(acc, A, lda, Bt, ldb, K, m0, n0, smem);
  u16* Ct = smem;
  __syncthreads();
#pragma unroll
  for (int i = 0; i < 2; ++i)
#pragma unroll
    for (int j = 0; j < 2; ++j)
#pragma unroll
      for (int r = 0; r < 16; ++r)
        Ct[(wm * 64 + i * 32 + (r & 3) + 8 * (r >> 2) + 4 * hh) * CLD + wn * 64 + j * 32 + l31] = f2bf(acc[i][j][r]);
  __syncthreads();
  if (kind == K_VT || kind == K_VTM) {
    const int d = tid >> 2, tc = tid & 3;
#pragma unroll 1
    for (int blk = 0; blk < 4; ++blk) {
      const int hsub = blk >> 1, tsub = blk & 1;
      unsigned u[8];
#pragma unroll
      for (int i = 0; i < 8; ++i)
        u[i] = (unsigned)Ct[(tsub * 64 + tc * 16 + 2 * i) * CLD + hsub * 64 + d] |
               ((unsigned)Ct[(tsub * 64 + tc * 16 + 2 * i + 1) * CLD + hsub * 64 + d] << 16);
      u16* dst;
      if (kind == K_VT) {
        const int b = m0 >> 12, tt = ((m0 & 4095) >> 6) + tsub;
        dst = base + ((size_t)((b * hb + hbase + hsub) * 64 + tt)) * 4096 + d * 64 + tc * 16;
      } else {
        const int b = m0 >> 8, mo = (m0 & 255) + tsub * 64;
        dst = base + ((size_t)((b * 4 + hbase + hsub) * 64 + d)) * 256 + mo + tc * 16;
      }
      u32x4 a = {u[0], u[1], u[4], u[5]}, bq = {u[2], u[3], u[6], u[7]};
      *(u32x4*)dst = a;
      *(u32x4*)(dst + 8) = bq;
    }
    return;
  }
  const int l16 = tid & 15, c8 = l16 * 8;
  float gn[8];
  {
    const int gi = (kind == K_N32R4) ? (l16 & 3) * 8 : (kind == K_GELU_N128) ? c8 : (l16 & 7) * 8;
#pragma unroll
    for (int i = 0; i < 8; ++i) gn[i] = (kind == K_PLAIN) ? 1.f : gain[gi + i];
  }
  const int r0 = tid >> 4;
  if (kind == K_PLAIN) {
#pragma unroll
    for (int ps = 0; ps < 8; ++ps) {
      const int row = ps * 16 + r0;
      *(u32x4*)(base + (size_t)(m0 + row) * ldc + n0 + c8) = *(const u32x4*)(Ct + row * CLD + c8);
    }
    return;
  }
  if (kind == K_N32R4) {
#pragma unroll
    for (int ps = 0; ps < 8; ++ps) {
      const int row = ps * 16 + r0, grow = m0 + row, t = grow & (SEQ - 1);
      float v[8];
      ld8(Ct + row * CLD + c8, v);
      const float4 cs0 = *(const float4*)(p.rope4 + t * 8), cs1 = *(const float4*)(p.rope4 + t * 8 + 4);
      const float rs = group_rs<4>(v);
#pragma unroll
      for (int i = 0; i < 8; ++i) v[i] = v[i] * rs * gn[i];
      if ((l16 & 3) == 0) {
        const float cc[4] = {cs0.x, cs0.y, cs0.z, cs0.w}, sn[4] = {cs1.x, cs1.y, cs1.z, cs1.w};
#pragma unroll
        for (int i = 0; i < 4; ++i) {
          float x1 = v[i], x2 = v[4 + i];
          v[i] = x1 * cc[i] - x2 * sn[i]; v[4 + i] = x1 * sn[i] + x2 * cc[i];
        }
      }
      st8(base + (size_t)grow * ldc + n0 + c8, v);
    }
    return;
  }
  if (kind == K_GELU_N128) {
#pragma unroll
    for (int ps = 0; ps < 8; ++ps) {
      const int row = ps * 16 + r0, grow = m0 + row;
      float v[8];
      ld8(Ct + row * CLD + c8, v);
#pragma unroll
      for (int i = 0; i < 8; ++i) v[i] = geluf_(v[i]);
      const float rs = group_rs<16>(v);
#pragma unroll
      for (int i = 0; i < 8; ++i) v[i] = v[i] * rs * gn[i];
      st8(base + (size_t)grow * ldc + n0 + c8, v);
    }
    return;
  }
  {
    const int sub = l16 & 7;
#pragma unroll
    for (int ps = 0; ps < 8; ++ps) {
      const int row = ps * 16 + r0, grow = m0 + row, t = grow & (SEQ - 1);
      float v[8];
      ld8(Ct + row * CLD + c8, v);
      float4 c0, c1, s0, s1;
      if (kind == K_N64R8) {
        c0 = *(const float4*)(p.rope8 + t * 16); c1 = *(const float4*)(p.rope8 + t * 16 + 4);
        s0 = *(const float4*)(p.rope8 + t * 16 + 8); s1 = *(const float4*)(p.rope8 + t * 16 + 12);
      }
      const float rs = group_rs<8>(v);
#pragma unroll
      for (int i = 0; i < 8; ++i) v[i] = v[i] * rs * gn[i];
      if (kind == K_N64R8) {
        const float cc[8] = {c0.x, c0.y, c0.z, c0.w, c1.x, c1.y, c1.z, c1.w};
        const float sn[8] = {s0.x, s0.y, s0.z, s0.w, s1.x, s1.y, s1.z, s1.w};
#pragma unroll
        for (int i = 0; i < 8; ++i) {
          const float other = __shfl_xor(v[i], 1);
          if (sub == 0) v[i] = v[i] * cc[i] - other * sn[i];
          else if (sub == 1) v[i] = other * sn[i] + v[i] * cc[i];
        }
      }
      st8(base + (size_t)grow * ldc + n0 + c8, v);
    }
  }
}

DI void phase_gemm_in2(const Params& p, int layer, u16* smem) {
  const u16* Bt = layer ? p.winT1 : p.winT0;
  const int ntn = layer ? 31 : 32;
  const int main_items = (T / 128) * ntn;
  const int extra = layer ? 0 : 2 * 8 * 4;
  for (int it = blockIdx.x; it < main_items + extra; it += gridDim.x) {
    if (it < main_items) {
      const int mt = it / ntn;
      const int nt = layer ? (it % ntn) : ((it % ntn) + 4 * (mt >> 4)) & 31;
      const int n0 = nt * 128;
      int kind = K_PLAIN, hb = 0, hbase = 0; u16* base = p.proj; const float* gain = nullptr;
      if (!layer) {
        if (n0 >= A_V && n0 < A_G) { kind = K_GELU_N128; gain = p.a_vnorm + (n0 - A_V); }
        else if (n0 >= B_Q && n0 < B_K) { kind = K_N32R4; gain = p.b_qnorm; }
        else if (n0 >= B_K && n0 < B_V) { kind = K_N32R4; gain = p.b_knorm; }
        else if (n0 >= B_V && n0 < B_G) { kind = K_VT; base = p.vT; hb = 8; hbase = (n0 - B_V) >> 6; }
        else if (n0 >= M0_Q && n0 < M0_G) { kind = K_N64; gain = p.m0_qnorm; }
      } else {
        if (n0 >= D_Q && n0 < D_KV) { kind = K_N64R8; gain = p.d_qnorm; }
        else if (n0 == D_KV + 256) { kind = K_N64R8; gain = p.d_knorm; }
        else if (n0 == D_KV + 384) { kind = K_VT; base = p.vsT; hb = 2; }
        else if (n0 == D_KV + 512) { kind = K_N64R8; gain = p.d_knorm; }
        else if (n0 == D_KV + 640) { kind = K_VT; base = p.vwT; hb = 2; }
        else if (n0 >= M1_Q && n0 < M1_G) { kind = K_N64; gain = p.m1_qnorm; }
      }
      gemm_tile_fused(p.h, 1024, Bt, 1024, 1024, mt * 128, n0, smem, kind, base, LDP, hb, hbase, gain, p);
    } else {
      const int e = it - main_items;
      const int l = e / 32, r = e % 32, mt = r / 4, nt = r % 4, n0 = nt * 128;
      u16* kvb = l ? p.memkv1 : p.memkv0;
      if (n0 < 256) gemm_tile_fused(p.memn, 1024, l ? p.wkvT1 : p.wkvT0, 1024, 1024, mt * 128, n0, smem, K_N64, kvb, 512, 0, 0, l ? p.m1_knorm : p.m0_knorm, p);
      else gemm_tile_fused(p.memn, 1024, l ? p.wkvT1 : p.wkvT0, 1024, 1024, mt * 128, n0, smem, K_VTM, l ? p.memvT1 : p.memvT0, 512, 0, (n0 - 256) >> 6, nullptr, p);
    }
  }
}

DI void phase_mid1(const Params& p, float* smf, int* qslot) {
  const int n_cmp = 2 * 4 * 2 * 8, n_conv = BATCH * 256, n_mem = BATCH * 4 * 32;
  unsigned* ctr = p.qctr + 32;
  int it = blockIdx.x;
  while (it < n_cmp) { compress_item_mfma(p, it, smf); it = queue_pull(ctr, qslot); }
  while (it < n_cmp + n_conv) { conv_item4(p, it - n_cmp, smf); it = queue_pull(ctr, qslot); }
  while (it < n_cmp + n_conv + n_mem) {
    const int e = it - n_cmp - n_conv;
    memattn_item(p, 1, (e >> 2) & 3, e & 3, e >> 4, (u16*)smf);
    it = queue_pull(ctr, qslot);
  }
}
#ifndef PROBE_MID
#define PROBE_MID 0
#endif
DI void phase_probe_mid(const Params& p, float* smf) {
  const int n_cmp = 2 * 4 * 2 * 8, n_conv = BATCH * 256, n_mem = BATCH * 4 * 32;
  if (PROBE_MID == 1) for (int it = blockIdx.x; it < n_cmp; it += gridDim.x) compress_item_mfma(p, it, smf);
  if (PROBE_MID == 2) for (int it = blockIdx.x; it < n_conv; it += gridDim.x) conv_item2(p, it, smf);
  if (PROBE_MID == 3) for (int e = blockIdx.x; e < n_mem; e += gridDim.x) memattn_item(p, 1, (e >> 2) & 3, e & 3, e >> 4, (u16*)smf);
}
DI void phase_nsa(const Params& p, float* smf, int* qslot) {
  const int n_nsa = BATCH * 2 * 128;
  int it = blockIdx.x;
  while (it < n_nsa) {
    const int qt = 127 - it / 8, bg = it % 8;
    nsa_item(p, bg >> 1, bg & 1, qt, (u16*)smf);
    it = queue_pull(p.qctr + 16, qslot);
  }
}

DI void phase_norm1(const Params& p) {
  const int lane = threadIdx.x & 63, w = threadIdx.x >> 6;
  for (int it = blockIdx.x; it < T / 4; it += gridDim.x) {
    int row = it * 4 + w;
    rmsnorm_row(p.out + (size_t)row * 1024, p.l1_norm, p.h + (size_t)row * 1024, lane);
  }
}

#define XB_TMO      128
#define XB_XCNT(j)  (256  + 64 * (j))
#define XB_XSUB(j)  (1280 + 64 * (j))
#define XB_XGEN(j)  (2304 + 64 * (j))
#define XB_TOP      3328
#define XB_TOPGEN   3392
#define XCD_BAR_WORDS 3456
#define XB_SPIN_CAP (1u << 18)
#define LAS __attribute__((address_space(3)))

__device__ __forceinline__ unsigned xb_ld(unsigned* p)              { return __hip_atomic_load(p, __ATOMIC_RELAXED, __HIP_MEMORY_SCOPE_AGENT); }
__device__ __forceinline__ unsigned xb_add(unsigned* p, unsigned v) { return __hip_atomic_fetch_add(p, v, __ATOMIC_RELAXED, __HIP_MEMORY_SCOPE_AGENT); }
__device__ __forceinline__ unsigned xb_xcc_id() { return (unsigned)__builtin_amdgcn_s_getreg((3 << 11) | 20) & 0xFu; }
#define XB_SPIN(cond, bar) do { unsigned _sp = 0; while (cond) { __builtin_amdgcn_s_sleep(1); \
    if ((++_sp & 255u) == 0u) { if (xb_ld(&(bar)[XB_TMO])) break; if (_sp > XB_SPIN_CAP) { atomicAdd(&(bar)[XB_TMO], 1u); break; } } } } while (0)

struct XcdBarrier {
    unsigned* bar; unsigned x;
    volatile LAS unsigned* st;
};

__device__ __forceinline__ XcdBarrier xcd_barrier_post(unsigned* bar, volatile LAS unsigned* st) {
    XcdBarrier b; b.bar = bar; b.x = xb_xcc_id(); b.st = st;
    if (threadIdx.x == 0) (void)xb_add(&bar[XB_XCNT(b.x)], 1u);
    return b;
}
__device__ __forceinline__ void xcd_barrier_complete(unsigned* bar, unsigned x, unsigned& nloc, unsigned& nx) {
    const unsigned G = gridDim.x * gridDim.y * gridDim.z;
    unsigned sum, cnt, mine, sp = 0u;
    for (;;) {
        sum = 0u; cnt = 0u; mine = 0u;
#pragma unroll
        for (unsigned j = 0; j < 16; ++j) { const unsigned c = xb_ld(&bar[XB_XCNT(j)]); sum += c; cnt += (c > 0u) ? 1u : 0u; mine = (j == x) ? c : mine; }
        if (sum == G) break;
        __builtin_amdgcn_s_sleep(1);
        if ((++sp & 255u) == 0u) { if (xb_ld(&bar[XB_TMO])) break; if (sp > XB_SPIN_CAP) { atomicAdd(&bar[XB_TMO], 1u); break; } }
    }
    nloc = mine > 0u ? mine : 1u; nx = cnt > 0u ? cnt : 1u;
}

__device__ __forceinline__ void xcd_barrier(const XcdBarrier& b) {
    asm volatile("s_waitcnt vmcnt(0)" ::: "memory");
    __syncthreads();
    if (threadIdx.x == 0) {
        unsigned* bar = b.bar;
        __builtin_amdgcn_s_waitcnt(0);
        unsigned nloc = b.st[0], nx = b.st[1];
        if (nloc == 0u) { xcd_barrier_complete(bar, b.x, nloc, nx); b.st[0] = nloc; b.st[1] = nx; }
        const unsigned old = xb_add(&bar[XB_XSUB(b.x)], 1u);
        const unsigned gen = old / nloc;
        if (old + 1u == (gen + 1u) * nloc) {
            __builtin_amdgcn_fence(__ATOMIC_RELEASE, "agent");
            asm volatile("s_waitcnt vmcnt(0)" ::: "memory");
            const unsigned og = xb_add(&bar[XB_TOP], 1u);
            const unsigned tg = og / nx;
            if (og + 1u == (tg + 1u) * nx) xb_add(&bar[XB_TOPGEN], 1u);
            else XB_SPIN(xb_ld(&bar[XB_TOPGEN]) == tg, bar);
            __builtin_amdgcn_fence(__ATOMIC_ACQUIRE, "agent");
            xb_add(&bar[XB_XGEN(b.x)], 1u);
            asm volatile("s_waitcnt vmcnt(0)" ::: "memory");
        } else {
            XB_SPIN(xb_ld(&bar[XB_XGEN(b.x)]) == gen, bar);
            __builtin_amdgcn_fence(__ATOMIC_ACQUIRE, "agent");
            asm volatile("s_waitcnt vmcnt(0)" ::: "memory");
        }
    }
    __syncthreads();
}

constexpr int NPHASE = 9;
#ifndef PHMASK
#define PHMASK 0x3ff
#endif
constexpr int LDS_BYTES = 45568;

__global__ void __launch_bounds__(256, 2) mega(Params p, int ph_lo, int ph_hi) {
  __shared__ __attribute__((aligned(16))) unsigned char smem_raw[LDS_BYTES];
  u16* smem = (u16*)smem_raw;
  float* smf = (float*)smem_raw;
#ifndef DUPMASK
#define DUPMASK 0
#endif
#define RUN_PHASE(n, call) if (ph_lo <= n && n < ph_hi) { if (PHMASK & (1 << n)) { call; } if (DUPMASK & (1 << n)) { __syncthreads(); call; } if (n + 1 < ph_hi) { xcd_barrier(xb); } }
  __shared__ uint4 xb_words;
  __shared__ int qslot;
  if (threadIdx.x == 0) xb_words = make_uint4(0u, 0u, 0u, 0u);
  __syncthreads();
  XcdBarrier xb = xcd_barrier_post(p.bar, (volatile LAS unsigned*)&xb_words);
  if (ph_hi > 1000) cg::this_grid().sync();
  RUN_PHASE(0, phase0(p, smf))
  RUN_PHASE(1, phase_gemm_in2(p, 0, smem))
  RUN_PHASE(2, phase_mix0(p, smem, &qslot))
  RUN_PHASE(3, phase_gemm_out(p, 0, smem))
  RUN_PHASE(4, phase_norm1(p))
  RUN_PHASE(5, phase_gemm_in2(p, 1, smem))
  RUN_PHASE(6, phase_mid1(p, smf, &qslot))
  RUN_PHASE(7, phase_nsa(p, smf, &qslot))
  RUN_PHASE(8, phase_gemm_out(p, 1, smem))
}

#ifndef ONE_LAUNCH
#define ONE_LAUNCH 1
#endif

extern "C" void kernel_launch(void* const* d_in, const int* in_sizes, int n_in, void* d_out, int out_size, void* d_ws,
                              size_t ws_size, hipStream_t stream) {
  Params p{};
  const float* const* in = (const float* const*)d_in;
  p.x = in[0]; p.mem = in[1]; p.mem_norm = in[2];
  p.l0_norm = in[3]; p.l0_w_in = in[4]; p.a_vnorm = in[5]; p.a_ws = in[6]; p.a_bs = in[7]; p.b_qnorm = in[8]; p.b_knorm = in[9];
  p.lq1 = in[10]; p.lk1 = in[11]; p.lq2 = in[12]; p.lk2 = in[13]; p.b_subln = in[14];
  p.m0_wkv = in[15]; p.m0_qnorm = in[16]; p.m0_knorm = in[17]; p.l0_w_out = in[18];
  p.l1_norm = in[19]; p.l1_w_in = in[20]; p.conv_w = in[21]; p.conv_b = in[22]; p.c_norm = in[23]; p.d_qnorm = in[24]; p.d_knorm = in[25];
  p.pos_k = in[26]; p.w1_k = in[27]; p.w2_k = in[28]; p.pos_v = in[29]; p.w1_v = in[30]; p.w2_v = in[31];
  p.m1_wkv = in[32]; p.m1_qnorm = in[33]; p.m1_knorm = in[34]; p.l1_w_out = in[35];
  p.out = (float*)d_out;
  unsigned char* ws = (unsigned char*)d_ws;
  size_t off = 0;
  auto take = [&](size_t bytes) { unsigned char* r = ws + off; off += (bytes + 255) & ~(size_t)255; return r; };
  p.h = (u16*)take((size_t)T * 1024 * 2);
  p.proj = (u16*)take((size_t)T * LDP * 2);
  p.ycat = (u16*)take((size_t)T * MIX * 2);
  p.winT0 = (u16*)take((size_t)4096 * 1024 * 2);
  p.winT1 = (u16*)take((size_t)ODD_PAD * 1024 * 2);
  p.woutT0 = (u16*)take((size_t)1024 * MIX * 2);
  p.woutT1 = (u16*)take((size_t)1024 * MIX * 2);
  p.wkvT0 = (u16*)take((size_t)512 * 1024 * 2);
  p.wkvT1 = (u16*)take((size_t)512 * 1024 * 2);
  p.memn = (u16*)take((size_t)1024 * 1024 * 2);
  p.memkv0 = (u16*)take((size_t)1024 * 512 * 2);
  p.memkv1 = (u16*)take((size_t)1024 * 512 * 2);
  p.kc = (u16*)take((size_t)8 * 256 * 64 * 2);
  p.vc = nullptr;
  p.rope4 = (float*)take((size_t)SEQ * 8 * 4);
  p.rope8 = (float*)take((size_t)SEQ * 16 * 4);
  p.cbias = (float*)take(2 * 32 * 128 * 4);
  p.bar = (unsigned*)take((XCD_BAR_WORDS + 64) * 4);
  p.qctr = p.bar + XCD_BAR_WORDS;
  p.vcT = (u16*)take((size_t)8 * 64 * 256 * 2);
  p.wsb = (u16*)take((size_t)4 * 128 * 128 * 2);
  p.w1T_k = (u16*)take((size_t)128 * 2048 * 2);
  p.w1T_v = (u16*)take((size_t)128 * 2048 * 2);
  p.memvT0 = (u16*)take((size_t)16 * 64 * 256 * 2);
  p.memvT1 = (u16*)take((size_t)16 * 64 * 256 * 2);
  u16* vtbuf = (u16*)take((size_t)32 * SEQ * 64 * 2);
  p.vT = vtbuf;
  p.vsT = vtbuf;
  p.vwT = vtbuf + (size_t)8 * SEQ * 64;
  p.kd = nullptr; p.ksd = nullptr; p.kwd = nullptr;
  if (off > ws_size) fprintf(stderr, "workspace too small: need %zu have %zu\n", off, ws_size);

  static int grid_blocks = 0;
  if (!grid_blocks) {
    int dev = 0, cus = 0, per_cu = 0;
    hipGetDevice(&dev);
    hipDeviceGetAttribute(&cus, hipDeviceAttributeMultiprocessorCount, dev);
    hipOccupancyMaxActiveBlocksPerMultiprocessor(&per_cu, mega, 256, 0);
    if (per_cu < 1) per_cu = 1;
    grid_blocks = cus * per_cu;
  }
#if ONE_LAUNCH
  hipMemsetAsync(p.bar, 0, (XCD_BAR_WORDS + 64) * 4, stream);
  int lo = 0, hi = NPHASE;
  void* args[] = {&p, &lo, &hi};
  hipError_t e = hipLaunchCooperativeKernel((void*)mega, dim3(grid_blocks), dim3(256), args, 0, stream);
  if (e != hipSuccess) fprintf(stderr, "cooperative launch failed: %s (grid %d)\n", hipGetErrorString(e), grid_blocks);
#else
  for (int ph = 0; ph < NPHASE; ++ph) hipLaunchKernelGGL(mega, dim3(grid_blocks), dim3(256), 0, stream, p, ph, ph + 1);
#endif
}
```
